# Optimizing an MI355X kernel written in HIP

```python
import math
import jax, jax.numpy as jnp
from jax import lax
import numpy as np

D_MODEL = 1024
BATCH = 8
SEQ = 4096
DEPTH = 2

EPS = 1e-6
NEG = -1e30
MIX_W = 512
HA = 4
DA = 64
A_OUT = HA * 2 * DA
QBLK = 128
WINDOWS = (128, 512, 2048)
DILATIONS = (1, 4, 16)
NG_B = 3
HB = 8
DB = 64
B_OUT = HB * DB
BLK_B = 64
CHUNK = 128
C_GROUPS = 4
C_WIDTH = 512
C_GDIM = C_WIDTH // C_GROUPS
N_BRANCH = 3
N_BUCKETS = 32
MAX_DIST = 128
N_BIAS_HEADS = HA + NG_B * HB
N_GROUPS = 4
E_PER_GROUP = 4
N_EXPERTS = N_GROUPS * E_PER_GROUP
TOP_K = 2
D_FF_EXPERT = 512
A_COLS = 3 * A_OUT
B_COLS = 3 * NG_B * HB * DB
C_COLS = 2 * C_WIDTH
G_COLS = N_BRANCH * D_MODEL
D_IN = A_COLS + B_COLS + C_COLS + G_COLS
SPLITS = (A_OUT, 2 * A_OUT, A_COLS, A_COLS + B_COLS, A_COLS + B_COLS + C_COLS)

kernel_name = "hybrid_diffattn_dilated_gmlp_hiermoe"


def rms_norm(x, g):
    xf = x.astype(jnp.float32)
    y = xf * lax.rsqrt(jnp.mean(xf * xf, axis=-1, keepdims=True) + EPS)
    return (y * g.astype(jnp.float32)).astype(x.dtype)


def layer_norm(x, g, b):
    xf = x.astype(jnp.float32)
    mu = jnp.mean(xf, axis=-1, keepdims=True)
    var = jnp.mean(jnp.square(xf - mu), axis=-1, keepdims=True)
    y = (xf - mu) * lax.rsqrt(var + EPS)
    return (y * g.astype(jnp.float32) + b.astype(jnp.float32)).astype(x.dtype)


def t5_bucket(rel):
    nb = N_BUCKETS // 2
    max_exact = nb // 2
    ret = (rel > 0).astype(jnp.int32) * nb
    n = jnp.abs(rel)
    nf = jnp.maximum(n, 1).astype(jnp.float32)
    large = max_exact + (jnp.log(nf / max_exact) / math.log(MAX_DIST / max_exact)
                         * (nb - max_exact)).astype(jnp.int32)
    large = jnp.minimum(large, nb - 1)
    return ret + jnp.where(n < max_exact, n, large)


def diff_attention(q, k, v, lam, lam_init, subln_g, bias_tab):
    B, S = q.shape[0], q.shape[1]
    nblk = S // QBLK
    scale = DA ** -0.5
    qb = q.reshape(B, nblk, QBLK, HA, 2, DA).transpose(1, 0, 2, 3, 4, 5)
    kpos = jnp.arange(S, dtype=jnp.int32)

    def one_block(args):
        qblk, start = args
        qpos = start + jnp.arange(QBLK, dtype=jnp.int32)
        bias = bias_tab.astype(jnp.float32)[t5_bucket(kpos[None, :] - qpos[:, None])]
        logits = jnp.einsum('bqhcd,bkhcd->bhcqk', qblk, k).astype(jnp.float32) * scale
        logits = logits + bias.transpose(2, 0, 1)[None, :, None]
        p = jax.nn.softmax(logits, axis=-1)
        attn = p[:, :, 0] - lam * p[:, :, 1]
        return jnp.einsum('bhqk,bkhe->bqhe', attn.astype(v.dtype), v)

    out = lax.map(one_block, (qb, jnp.arange(nblk, dtype=jnp.int32) * QBLK))
    out = out.transpose(1, 0, 2, 3, 4).reshape(B, S, HA, 2 * DA)
    out = rms_norm(out, subln_g) * (1.0 - lam_init)
    return out.reshape(B, S, A_OUT)


def dilated_group_attention(q, k, v, bias_tab, window, r):
    B, S, H, d = q.shape
    L = S // r
    nb = -(-L // BLK_B)
    Lp = nb * BLK_B
    half = window // (2 * r)

    def to_sub(t):
        t = t.reshape(B, L, r, H, d).transpose(0, 2, 1, 3, 4)
        return jnp.pad(t, ((0, 0), (0, 0), (0, Lp - L), (0, 0), (0, 0)))

    def band(t):
        t = jnp.pad(t, ((0, 0), (0, 0), (BLK_B, BLK_B), (0, 0), (0, 0)))
        t = t.reshape(B, r, nb + 2, BLK_B, H, d)
        return jnp.concatenate([t[:, :, :-2], t[:, :, 1:-1], t[:, :, 2:]], axis=3)

    qs = to_sub(q).reshape(B, r, nb, BLK_B, H, d)
    kb = band(to_sub(k))
    vb = band(to_sub(v))
    logits = jnp.einsum('brnqhd,brnkhd->brnhqk', qs, kb).astype(jnp.float32) * (d ** -0.5)
    qi = jnp.arange(BLK_B, dtype=jnp.int32)[:, None]
    ki = jnp.arange(3 * BLK_B, dtype=jnp.int32)[None, :] - BLK_B
    rel = ki - qi
    bias = bias_tab.astype(jnp.float32)[t5_bucket(rel * r)].transpose(2, 0, 1)
    kidx = jnp.arange(nb, dtype=jnp.int32)[:, None, None] * BLK_B + ki[None]
    valid = (jnp.abs(rel) <= half)[None] & (kidx >= 0) & (kidx < L)
    logits = jnp.where(valid[None, None, :, None], logits + bias, NEG)
    lse = jax.nn.logsumexp(logits, axis=-1)
    p = jnp.exp(logits - lse[..., None])
    out = jnp.einsum('brnhqk,brnkhd->brnqhd', p.astype(v.dtype), vb)
    out = out.reshape(B, r, Lp, H, d)[:, :, :L].transpose(0, 2, 1, 3, 4).reshape(B, S, H, d)
    lse = lse.transpose(0, 1, 2, 4, 3).reshape(B, r, Lp, H)[:, :, :L]
    lse = lse.transpose(0, 2, 1, 3).reshape(B, S, H)
    return out, lse


def dilated_attention(qkv, rel_bias):
    B, S = qkv.shape[0], qkv.shape[1]
    qkv = qkv.reshape(B, S, 3, NG_B, HB, DB)
    outs, lses = [], []
    for g in range(NG_B):
        tab = rel_bias[:, HA + g * HB: HA + (g + 1) * HB]
        o, l = dilated_group_attention(qkv[:, :, 0, g], qkv[:, :, 1, g], qkv[:, :, 2, g],
                                       tab, WINDOWS[g], DILATIONS[g])
        outs.append(o)
        lses.append(l)
    w = jax.nn.softmax(jnp.stack(lses, axis=0), axis=0)
    y = jnp.sum(w[..., None].astype(qkv.dtype) * jnp.stack(outs, axis=0), axis=0)
    return y.reshape(B, S, B_OUT)


def chunked_sgu(z, ln_g, ln_b, w_s, b_s):
    B, S = z.shape[0], z.shape[1]
    z = jax.nn.gelu(z)
    u, v = z[..., :C_WIDTH], z[..., C_WIDTH:]
    v = layer_norm(v, ln_g, ln_b)
    vc = v.reshape(B, S // CHUNK, CHUNK, C_GROUPS, C_GDIM)
    mixed = jnp.einsum('gpq,bnqgc->bnpgc', w_s, vc) + b_s.T[None, None, :, :, None]
    return u * mixed.reshape(B, S, C_WIDTH)


def hier_moe(h, w_rg, b_rg, w_re, b_re, w_gate, w_up, w_down):
    B, S, D = h.shape
    t = h.reshape(B * S, D)
    T = t.shape[0]
    grp_logits = (t @ w_rg).astype(jnp.float32) + b_rg.astype(jnp.float32)
    grp_prob = jax.nn.softmax(grp_logits, axis=-1)
    g_idx = jnp.argmax(grp_logits, axis=-1)
    g_w = jnp.max(grp_prob, axis=-1, keepdims=True)
    exp_logits = jnp.einsum('td,gde->tge', t, w_re).astype(jnp.float32) + b_re.astype(jnp.float32)
    sel = exp_logits[jnp.arange(T), g_idx]
    top_v, top_i = lax.top_k(sel, TOP_K)
    top_w = jax.nn.softmax(top_v, axis=-1) * g_w
    ex_idx = g_idx[:, None] * E_PER_GROUP + top_i
    combine = jnp.sum(jax.nn.one_hot(ex_idx, N_EXPERTS, dtype=jnp.float32) * top_w[..., None], axis=1)
    combine = combine.astype(t.dtype)
    out = jnp.zeros_like(t)
    for e in range(N_EXPERTS):
        hid = jax.nn.silu(t @ w_gate[e]) * (t @ w_up[e])
        out = out + combine[:, e:e + 1] * (hid @ w_down[e])
    return out.reshape(B, S, D)


def setup_inputs(seed: int = 0) -> dict:
    key = jax.random.key(seed)
    ks = jax.random.split(key, 24)

    def nrm(k, shape, scale):
        return jax.random.normal(k, shape, jnp.float32) * scale

    return {
        "x": nrm(ks[0], (BATCH, SEQ, D_MODEL), 1.0),
        "rel_bias": nrm(ks[1], (N_BUCKETS, N_BIAS_HEADS), 0.2),
        "norm_mix": 1.0 + nrm(ks[2], (DEPTH, D_MODEL), 0.02),
        "w_in": nrm(ks[3], (DEPTH, D_MODEL, D_IN), D_MODEL ** -0.5),
        "diff_lambda": nrm(ks[4], (DEPTH, 4, DA), 0.1),
        "diff_subln": 1.0 + nrm(ks[5], (DEPTH, 2 * DA), 0.02),
        "sgu_ln_g": 1.0 + nrm(ks[6], (DEPTH, C_WIDTH), 0.02),
        "sgu_ln_b": nrm(ks[7], (DEPTH, C_WIDTH), 0.02),
        "sgu_w": nrm(ks[8], (DEPTH, C_GROUPS, CHUNK, CHUNK), CHUNK ** -0.5),
        "sgu_b": 1.0 + nrm(ks[9], (DEPTH, C_GROUPS, CHUNK), 0.02),
        "w_branch": nrm(ks[10], (DEPTH, N_BRANCH, MIX_W, D_MODEL), MIX_W ** -0.5),
        "w_out": nrm(ks[11], (DEPTH, D_MODEL, D_MODEL), D_MODEL ** -0.5),
        "norm_ffn": 1.0 + nrm(ks[12], (DEPTH, D_MODEL), 0.02),
        "w_router_grp": nrm(ks[13], (DEPTH, D_MODEL, N_GROUPS), D_MODEL ** -0.5),
        "b_router_grp": nrm(ks[14], (DEPTH, N_GROUPS), 0.01),
        "w_router_exp": nrm(ks[15], (DEPTH, N_GROUPS, D_MODEL, E_PER_GROUP), D_MODEL ** -0.5),
        "b_router_exp": nrm(ks[16], (DEPTH, N_GROUPS, E_PER_GROUP), 0.01),
        "w_gate": nrm(ks[17], (DEPTH, N_EXPERTS, D_MODEL, D_FF_EXPERT), D_MODEL ** -0.5),
        "w_up": nrm(ks[18], (DEPTH, N_EXPERTS, D_MODEL, D_FF_EXPERT), D_MODEL ** -0.5),
        "w_down": nrm(ks[19], (DEPTH, N_EXPERTS, D_FF_EXPERT, D_MODEL), D_FF_EXPERT ** -0.5),
        "norm_final": 1.0 + nrm(ks[20], (D_MODEL,), 0.02),
    }


def reference(x, rel_bias, norm_mix, w_in, diff_lambda, diff_subln, sgu_ln_g, sgu_ln_b,
              sgu_w, sgu_b, w_branch, w_out, norm_ffn, w_router_grp, b_router_grp,
              w_router_exp, b_router_exp, w_gate, w_up, w_down, norm_final):
    B, S, D = x.shape
    for i in range(DEPTH):
        h = rms_norm(x, norm_mix[i])
        proj = h @ w_in[i]
        qa, ka, va, qkv_b, zc, gates = jnp.split(proj, SPLITS, axis=-1)
        lam_init = 0.8 - 0.6 * math.exp(-0.3 * i)
        lp = diff_lambda[i].astype(jnp.float32)
        lam = jnp.exp(jnp.sum(lp[0] * lp[1])) - jnp.exp(jnp.sum(lp[2] * lp[3])) + lam_init
        ya = diff_attention(qa.reshape(B, S, HA, 2, DA), ka.reshape(B, S, HA, 2, DA),
                            va.reshape(B, S, HA, 2 * DA), lam, lam_init, diff_subln[i],
                            rel_bias[:, :HA])
        yb = dilated_attention(qkv_b, rel_bias)
        yc = chunked_sgu(zc, sgu_ln_g[i], sgu_ln_b[i], sgu_w[i], sgu_b[i])
        branches = jnp.stack([ya, yb, yc], axis=2)
        g = jax.nn.sigmoid(gates.reshape(B, S, N_BRANCH, D))
        merged = jnp.sum(g * jnp.einsum('bsgi,gid->bsgd', branches, w_branch[i]), axis=2)
        x = x + merged @ w_out[i]
        h = rms_norm(x, norm_ffn[i])
        x = x + hier_moe(h, w_router_grp[i], b_router_grp[i], w_router_exp[i], b_router_exp[i],
                         w_gate[i], w_up[i], w_down[i])
    return rms_norm(x, norm_final)
```

```cpp
#include <hip/hip_runtime.h>
#include <cstdio>
#include <cstdint>

#ifndef MK_ONE_LAUNCH
#define MK_ONE_LAUNCH 1
#endif
#ifndef ONLY_PHASE
#define ONLY_PHASE -1
#endif
#define PHE(k) (ONLY_PHASE < 0 || ONLY_PHASE == (k))
#ifndef PROBE_VAR
#define PROBE_VAR 0
#endif
#ifndef HOST_DUPMASK
#define HOST_DUPMASK 0
#endif

constexpr int BATCH = 8, SEQ = 4096, DM = 1024, T = BATCH * SEQ, DEPTH = 2;
constexpr int D_IN = 10240, N_AC = 2560, N_B = 4608, N_G = 3072;
constexpr int NEXP = 16, DFF = 512, NBUCKET = 24, LISTCAP = 32768;
constexpr float EPS = 1e-6f;
constexpr float LOG2E = 1.4426950408889634f;
constexpr float da_QSC = 0.125f * LOG2E;

constexpr size_t MiB = 1u << 20;
constexpr size_t WS_CTL = 0, CTL_ZERO_BYTES = 64 * 1024;
constexpr size_t WS_BTA = 1 * MiB;
constexpr size_t WS_BTB = WS_BTA + 4 * 8192 * 4;
constexpr size_t WS_SGW = WS_BTA + 512 * 1024;
constexpr size_t WS_WIN = 2 * MiB;
constexpr size_t WS_WBR = 22 * MiB;
constexpr size_t WS_WOUT = 25 * MiB;
constexpr size_t WS_LIST = 27 * MiB;
constexpr size_t WS_TW = 30 * MiB;
constexpr size_t WS_H = 32 * MiB;
constexpr size_t WS_Y = 96 * MiB;
constexpr size_t WS_WGU = WS_Y, WS_WD = WS_Y + 32 * MiB;
constexpr size_t WS_P = 192 * MiB;
constexpr size_t WS_OA = WS_P + 160 * MiB;
constexpr size_t WS_H8 = 480 * MiB;
constexpr size_t WS_END = 512 * MiB;
constexpr int CW_BAR = 4096, CW_CNT = 8192;

constexpr int RING_BYTES = 131072, LDS_BYTES = 147456, MISC_OFF = LDS_BYTES - 1024;
constexpr int NWAVES = 8;

#define GAS __attribute__((address_space(1)))
#define LAS __attribute__((address_space(3)))
typedef unsigned short bf16;
typedef unsigned v4u __attribute__((ext_vector_type(4)));
typedef unsigned v2u __attribute__((ext_vector_type(2)));
typedef float f32x4 __attribute__((ext_vector_type(4)));
typedef float f32x16 __attribute__((ext_vector_type(16)));
typedef short bf16x8 __attribute__((ext_vector_type(8)));
typedef short s16x4 __attribute__((ext_vector_type(4)));
#define LDS_WAIT() asm volatile("s_waitcnt lgkmcnt(0)" ::: "memory")
#define VM_WAIT() asm volatile("s_waitcnt vmcnt(0)" ::: "memory")
__device__ __forceinline__ unsigned f2bf(float f) { unsigned u = __builtin_bit_cast(unsigned, f); return (u + 0x7fffu + ((u >> 16) & 1u)) >> 16; }
__device__ __forceinline__ float bf2f(unsigned b) { return __builtin_bit_cast(float, b << 16); }
__device__ __forceinline__ float bflo(unsigned w) { return __builtin_bit_cast(float, w << 16); }
__device__ __forceinline__ float bfhi(unsigned w) { return __builtin_bit_cast(float, w & 0xffff0000u); }
typedef float f32x2_t __attribute__((ext_vector_type(2))); typedef __bf16 bf16x2_t __attribute__((ext_vector_type(2)));
__device__ __forceinline__ unsigned pk2(float lo, float hi) { f32x2_t v = {lo, hi}; bf16x2_t b = __builtin_convertvector(v, bf16x2_t); return __builtin_bit_cast(unsigned, b); }
__device__ __forceinline__ unsigned cvt_pk_bf16(float lo, float hi) { f32x2_t v = {lo, hi}; bf16x2_t b = __builtin_convertvector(v, bf16x2_t); return __builtin_bit_cast(unsigned, b); }
__device__ __forceinline__ unsigned pk4_fp8(float a, float b, float c, float d) { unsigned w = 0; w = __builtin_amdgcn_cvt_pk_fp8_f32(a, b, w, false); w = __builtin_amdgcn_cvt_pk_fp8_f32(c, d, w, true); return w; }
__device__ __forceinline__ const char* sbase(const char* p) { size_t z = 0; asm volatile("" : "+s"(z)); return p + z; }
__device__ __forceinline__ int crow(int r, int hi) { return (r & 3) + 8 * (r >> 2) + 4 * hi; }
template <int M> __device__ __forceinline__ float swz_xor(float v) { return __builtin_bit_cast(float, __builtin_amdgcn_ds_swizzle(__builtin_bit_cast(int, v), (M << 10) | 0x1F)); }
template <int CTRL, int ROWS> __device__ __forceinline__ float dpp_add(float x) { return x + __builtin_bit_cast(float, __builtin_amdgcn_update_dpp(0, __builtin_bit_cast(int, x), CTRL, ROWS, 0xF, false)); }
__device__ __forceinline__ float row_sums(float v) { v = dpp_add<0xB1, 0xF>(v); v = dpp_add<0x4E, 0xF>(v); v = dpp_add<0x141, 0xF>(v); v = dpp_add<0x140, 0xF>(v); return v; }
__device__ __forceinline__ float half_sum(float v, int hi) {
    v = dpp_add<0x142, 0xA>(row_sums(v)); const int a = __builtin_bit_cast(int, v);
    const float lo_ = __builtin_bit_cast(float, __builtin_amdgcn_readlane(a, 31)), hi_ = __builtin_bit_cast(float, __builtin_amdgcn_readlane(a, 63));
    return hi ? hi_ : lo_; }
__device__ __forceinline__ float wave_sum(float v) {
    v = dpp_add<0x143, 0xC>(dpp_add<0x142, 0xA>(row_sums(v)));
    return __builtin_bit_cast(float, __builtin_amdgcn_readlane(__builtin_bit_cast(int, v), 63));
}

#define XB_TMO      128
#define XB_XCNT(j)  (256  + 64 * (j))
#define XB_XSUB(j)  (1280 + 64 * (j))
#define XB_XGEN(j)  (2304 + 64 * (j))
#define XB_TOP      3328
#define XB_TOPGEN   3392
#define XCD_BAR_WORDS 3456
#define XB_SPIN_CAP (1u << 18)
__device__ __forceinline__ unsigned xb_ld(unsigned* p)              { return __hip_atomic_load(p, __ATOMIC_RELAXED, __HIP_MEMORY_SCOPE_AGENT); }
__device__ __forceinline__ unsigned xb_add(unsigned* p, unsigned v) { return __hip_atomic_fetch_add(p, v, __ATOMIC_RELAXED, __HIP_MEMORY_SCOPE_AGENT); }
__device__ __forceinline__ unsigned xb_xcc_id() { return (unsigned)__builtin_amdgcn_s_getreg((3 << 11) | 20) & 0xFu; }
#define XB_SPIN(cond, bar) do { unsigned _sp = 0; while (cond) { __builtin_amdgcn_s_sleep(1); \
    if ((++_sp & 255u) == 0u) { if (xb_ld(&(bar)[XB_TMO])) break; if (_sp > XB_SPIN_CAP) { atomicAdd(&(bar)[XB_TMO], 1u); break; } } } } while (0)
struct XcdBarrier { unsigned* bar; unsigned x; volatile LAS unsigned* st; };
__device__ __forceinline__ XcdBarrier xcd_barrier_post(unsigned* bar, volatile LAS unsigned* st) {
    XcdBarrier b; b.bar = bar; b.x = xb_xcc_id(); b.st = st;
    if (threadIdx.x == 0) (void)xb_add(&bar[XB_XCNT(b.x)], 1u);
    return b;
}
__device__ __forceinline__ void xcd_barrier_complete(unsigned* bar, unsigned x, unsigned& nloc, unsigned& nx) {
    const unsigned G = gridDim.x * gridDim.y * gridDim.z;
    unsigned sum, cnt, mine, sp = 0u;
    for (;;) {
        sum = 0u; cnt = 0u; mine = 0u;
#pragma unroll
        for (unsigned j = 0; j < 16; ++j) { const unsigned c = xb_ld(&bar[XB_XCNT(j)]); sum += c; cnt += (c > 0u) ? 1u : 0u; mine = (j == x) ? c : mine; }
        if (sum == G) break;
        __builtin_amdgcn_s_sleep(1);
        if ((++sp & 255u) == 0u) { if (xb_ld(&bar[XB_TMO])) break; if (sp > XB_SPIN_CAP) { atomicAdd(&bar[XB_TMO], 1u); break; } }
    }
    nloc = mine > 0u ? mine : 1u; nx = cnt > 0u ? cnt : 1u;
}
__device__ __forceinline__ void xcd_barrier(const XcdBarrier& b) {
    asm volatile("s_waitcnt vmcnt(0)" ::: "memory");
    __syncthreads();
    if (threadIdx.x == 0) {
        unsigned* bar = b.bar;
        __builtin_amdgcn_s_waitcnt(0);
        unsigned nloc = b.st[0], nx = b.st[1];
        if (nloc == 0u) { xcd_barrier_complete(bar, b.x, nloc, nx); b.st[0] = nloc; b.st[1] = nx; }
        const unsigned old = xb_add(&bar[XB_XSUB(b.x)], 1u);
        const unsigned gen = old / nloc;
        if (old + 1u == (gen + 1u) * nloc) {
            __builtin_amdgcn_fence(__ATOMIC_RELEASE, "agent");
            asm volatile("s_waitcnt vmcnt(0)" ::: "memory");
            const unsigned og = xb_add(&bar[XB_TOP], 1u);
            const unsigned tg = og / nx;
            if (og + 1u == (tg + 1u) * nx) xb_add(&bar[XB_TOPGEN], 1u);
            else XB_SPIN(xb_ld(&bar[XB_TOPGEN]) == tg, bar);
            __builtin_amdgcn_fence(__ATOMIC_ACQUIRE, "agent");
            xb_add(&bar[XB_XGEN(b.x)], 1u);
            asm volatile("s_waitcnt vmcnt(0)" ::: "memory");
        } else {
            XB_SPIN(xb_ld(&bar[XB_XGEN(b.x)]) == gen, bar);
            __builtin_amdgcn_fence(__ATOMIC_ACQUIRE, "agent");
            asm volatile("s_waitcnt vmcnt(0)" ::: "memory");
        }
    }
    __syncthreads();
}

namespace pg8 {
constexpr int BM = 256, BK = 64, HALF = 128, HTB = HALF * BK * 2, STAGE_BYTES = 8 * HTB, NXCD = 8, WGM = 8;
__host__ __device__ __forceinline__ int lds_byte(int r, int c) { const int st = (r >> 4) * 2 + (c >> 5), rr = r & 15, cc = c & 31, ob = rr * 64 + cc * 2; return st * 1024 + (ob ^ (((ob >> 9) & 1) << 5)); }
__host__ __device__ __forceinline__ void stage_rc(int b, int& R, int& C) { const int st = b / 1024, sb = b % 1024, swz = sb ^ (((sb >> 9) & 1) << 5); R = (st >> 1) * 16 + swz / 64; C = (st & 1) * 32 + (swz % 64) / 2; }
__host__ __device__ __forceinline__ int perm32(int rho) { const int n = rho >> 4, i = rho & 15; return 8 * (i >> 2) + 4 * n + (i & 3); }
struct Unit { int pm, pn, q, cnt; };
typedef f32x4 Acc[2][2][4][2];
typedef int v4i_t __attribute__((ext_vector_type(4)));
__device__ __forceinline__ bool dense_next(int nM, int nN, int G, int c, int i, Unit& u) {
    const int nwg = nM * nN; const long L = (long)i * G + c; if (L >= nwg) return false;
    int wgid = (int)L; { const int q = nwg / NXCD, r = nwg % NXCD, xcd = wgid % NXCD, off = wgid / NXCD; wgid = (xcd < r ? xcd * (q + 1) : r * (q + 1) + (xcd - r) * q) + off; }
    const int nig = WGM * nN, gid = wgid / nig, fm = gid * WGM, gsz = (nM - fm) < WGM ? (nM - fm) : WGM;
    u.pm = fm + ((wgid % nig) % gsz); u.pn = (wgid % nig) / gsz; u.q = 0; u.cnt = 256; return true;
}
__device__ __forceinline__ void lane_rc(int& R, int& C) { int t = threadIdx.x; asm volatile("" : "+v"(t)); stage_rc(t * 16, R, C); }
template <class P>
__device__ __forceinline__ void gemm_phase(LAS unsigned char* lds, const P& p) {
    int tid = threadIdx.x; asm volatile("" : "+v"(tid));
    const int wid = __builtin_amdgcn_readfirstlane(tid >> 6), lane = tid & 63, wr = wid >> 2, wc = wid & 3, fr = lane & 15, fq = lane >> 4;
    constexpr int nt = P::NT; constexpr int NA = P::GATHER ? 4 : 1;
    unsigned voffB;
    constexpr bool F8 = P::FP8;
    { int R0, C0; stage_rc(tid * 16, R0, C0); const int Rb = P::PERM ? ((R0 & ~31) + perm32(R0 & 31)) : R0; voffB = (unsigned)(Rb * P::RBB + C0 * 2); }
    constexpr size_t qstepB = (size_t)64 * P::RBB, qstepA = (size_t)64 * P::RBA;
    const unsigned ldsw = (unsigned)wid * 1024u;
    const int aoff = lds_byte(wr * 64 + fr, F8 ? fq * 16 : fq * 8), boff = lds_byte(wc * 32 + fr, F8 ? fq * 16 : fq * 8);
    constexpr int KOFF = F8 ? 16 : 1024;
#define PG8_SA(b, h) (((b) * 2 + (h)) * HTB)
#define PG8_SB(b, h) ((4 + (b) * 2 + (h)) * HTB)
#define PG8_GLDS(gp, bufoff, i) __builtin_amdgcn_global_load_lds((const unsigned*)(gp), (LAS unsigned*)(lds + (bufoff) + ldsw + (i) * 8192), 16, 0, 0)
#define PG8_STAGE_B(bufoff, gbase, h) do { _Pragma("unroll") for (int _i = 0; _i < 2; ++_i) PG8_GLDS((const char*)(gbase) + (size_t)(2 * (h) + _i) * qstepB + voffB, bufoff, _i); } while (0)
#define PG8_STAGE_A(bufoff, gbase, h, ao) do { _Pragma("unroll") for (int _i = 0; _i < 2; ++_i) { \
        if constexpr (P::GATHER) PG8_GLDS((const char*)(gbase) + (ao)[2 * (h) + _i], bufoff, _i); else PG8_GLDS((const char*)(gbase) + (size_t)(2 * (h) + _i) * qstepA + (ao)[0], bufoff, _i); } } while (0)
#define PG8_LDA(dst, b, h) do { _Pragma("unroll") for (int m = 0; m < 4; ++m) _Pragma("unroll") for (int k = 0; k < 2; ++k) dst[m][k] = *(const LAS bf16x8*)(lds + PG8_SA(b, h) + aoff + m * 2048 + k * KOFF); } while (0)
#define PG8_LDB(dst, b, h) do { _Pragma("unroll") for (int n = 0; n < 2; ++n) _Pragma("unroll") for (int k = 0; k < 2; ++k) dst[n][k] = *(const LAS bf16x8*)(lds + PG8_SB(b, h) + boff + n * 2048 + k * KOFF); } while (0)
#define PG8_CAT(X) __builtin_shufflevector(__builtin_bit_cast(v4i_t, (X)[0]), __builtin_bit_cast(v4i_t, (X)[1]), 0, 1, 2, 3, 4, 5, 6, 7)
#define PG8_MMA(ai, bj, At, Bt) do { __builtin_amdgcn_s_setprio(1); \
        if constexpr (F8) { _Pragma("unroll") for (int m = 0; m < 4; ++m) _Pragma("unroll") for (int n = 0; n < 2; ++n) \
            asm volatile("v_mfma_scale_f32_16x16x128_f8f6f4 %0, %1, %2, %0, %3, %3 op_sel_hi:[0,0,0]" : "+v"(acc[ai][bj][m][n]) : "v"(PG8_CAT(Bt[n])), "v"(PG8_CAT(At[m])), "v"(mxsc)); } \
        else { _Pragma("unroll") for (int m = 0; m < 4; ++m) _Pragma("unroll") for (int n = 0; n < 2; ++n) _Pragma("unroll") for (int k = 0; k < 2; ++k) \
            acc[ai][bj][m][n] = __builtin_amdgcn_mfma_f32_16x16x32_bf16(Bt[n][k], At[m][k], acc[ai][bj][m][n], 0, 0, 0); } \
        __builtin_amdgcn_s_setprio(0); } while (0)
#define PG8_WAIT_V(n) asm volatile("s_waitcnt vmcnt(" #n ")" ::: "memory")
#define PG8_WAIT_L(n) asm volatile("s_waitcnt lgkmcnt(" #n ")" ::: "memory")
#define PG8_BAR __builtin_amdgcn_s_barrier()
#define PG8_SCHED __builtin_amdgcn_sched_barrier(0)
    Unit cur, nxt; int ui = 0;
    if (!p.next(0, cur)) return;
    Acc acc;
#pragma unroll
    for (int a = 0; a < 2; ++a)
#pragma unroll
        for (int b = 0; b < 2; ++b)
#pragma unroll
            for (int m = 0; m < 4; ++m)
#pragma unroll
                for (int n = 0; n < 2; ++n) acc[a][b][m][n] = (f32x4){0.f, 0.f, 0.f, 0.f};
    bf16x8 At[4][2], B0[2][2], B1[2][2];
    const int mxsc = 0x7F7F7F7F;
    unsigned aC[NA], aN[NA];
    { int R0, C0; lane_rc(R0, C0); p.a_off(cur, R0, C0, aC); }
    {
        const char* a0 = p.a_base(cur, 0); const char* b0 = p.b_base(cur, 0); const char* a1 = p.a_base(cur, 1); const char* b1 = p.b_base(cur, 1);
        PG8_STAGE_B(PG8_SB(0, 0), b0, 0); PG8_STAGE_B(PG8_SB(0, 1), b0, 1); PG8_STAGE_A(PG8_SA(0, 0), a0, 0, aC); PG8_STAGE_A(PG8_SA(0, 1), a0, 1, aC);
        if (wr == 1) PG8_BAR;
        PG8_WAIT_V(2); PG8_BAR;
        PG8_STAGE_B(PG8_SB(1, 0), b1, 0); PG8_STAGE_A(PG8_SA(1, 0), a1, 0, aC); PG8_STAGE_B(PG8_SB(1, 1), b1, 1);
        PG8_WAIT_V(6); PG8_BAR;
    }
    for (;;) {
        const bool has_next = p.next(ui + 1, nxt);
        if (has_next) { int R0, C0; lane_rc(R0, C0); p.a_off(nxt, R0, C0, aN); }
        else { nxt = cur;
#pragma unroll
            for (int i = 0; i < NA; ++i) aN[i] = aC[i]; }
#pragma unroll 1
        for (int t = 0; t < nt; t += 2) {
            const bool last = (t == nt - 2);
            if constexpr (P::HAS_MID) p.mid(acc, cur, t, wr, wc, fr, fq);
            const char* a1 = p.a_base(cur, t + 1);
            const char* a2 = last ? p.a_base(nxt, 0) : p.a_base(cur, t + 2); const char* b2 = last ? p.b_base(nxt, 0) : p.b_base(cur, t + 2);
            const char* a3 = last ? p.a_base(nxt, 1) : p.a_base(cur, t + 3); const char* b3 = last ? p.b_base(nxt, 1) : p.b_base(cur, t + 3);
            PG8_LDB(B0, 0, 0); PG8_LDB(B1, 0, 1); PG8_SCHED; PG8_LDA(At, 0, 0); PG8_STAGE_A(PG8_SA(1, 1), a1, 1, aC);
            if (last) {
#pragma unroll
                for (int i = 0; i < NA; ++i) aC[i] = aN[i]; }
            PG8_WAIT_V(8); PG8_WAIT_L(0); PG8_BAR; PG8_MMA(0, 0, At, B0); PG8_MMA(0, 1, At, B1); PG8_BAR; PG8_SCHED;
            PG8_LDA(At, 0, 1); PG8_STAGE_B(PG8_SB(0, 0), b2, 0); PG8_STAGE_B(PG8_SB(0, 1), b2, 1); PG8_STAGE_A(PG8_SA(0, 0), a2, 0, aC);
            PG8_WAIT_V(8); PG8_WAIT_L(0); PG8_BAR; PG8_MMA(1, 0, At, B0); PG8_MMA(1, 1, At, B1); PG8_BAR; PG8_SCHED;
            PG8_LDB(B0, 1, 0); PG8_LDB(B1, 1, 1); PG8_SCHED; PG8_LDA(At, 1, 0); PG8_STAGE_A(PG8_SA(0, 1), a2, 1, aC);
            PG8_WAIT_V(8); PG8_WAIT_L(0); PG8_BAR; PG8_MMA(0, 0, At, B0); PG8_MMA(0, 1, At, B1); PG8_BAR; PG8_SCHED;
            PG8_LDA(At, 1, 1); PG8_STAGE_B(PG8_SB(1, 0), b3, 0); PG8_STAGE_B(PG8_SB(1, 1), b3, 1); PG8_STAGE_A(PG8_SA(1, 0), a3, 0, aC);
            PG8_WAIT_V(8); PG8_WAIT_L(0); PG8_BAR; PG8_MMA(1, 0, At, B0); PG8_MMA(1, 1, At, B1); PG8_BAR; PG8_SCHED;
        }
        if (wr == 0) PG8_BAR;
        if constexpr (F8) asm volatile("s_nop 15\n\ts_nop 15" ::: "memory");
        p.epi(acc, cur, wr, wc, fr, fq);
        if (!has_next) break;
#pragma unroll
        for (int a = 0; a < 2; ++a)
#pragma unroll
            for (int b = 0; b < 2; ++b)
#pragma unroll
                for (int m = 0; m < 4; ++m)
#pragma unroll
                    for (int n = 0; n < 2; ++n) acc[a][b][m][n] = (f32x4){0.f, 0.f, 0.f, 0.f};
        cur = nxt; ++ui;
        if (wr == 1) PG8_BAR;
    }
    PG8_WAIT_V(0);
    PG8_BAR;
#undef PG8_SA
#undef PG8_SB
#undef PG8_GLDS
#undef PG8_STAGE_A
#undef PG8_STAGE_B
#undef PG8_LDA
#undef PG8_LDB
#undef PG8_MMA
#undef PG8_CAT
#undef PG8_WAIT_V
#undef PG8_WAIT_L
#undef PG8_BAR
#undef PG8_SCHED
}
}
using pg8::Unit; using pg8::Acc;

struct Args { const float* in[21]; float* out; unsigned char* ws; int ph_lo, ph_hi, dry, pad; };

struct DenseBase {
    const char* A; const char* B; int nM, nN, G, c;
    __device__ __forceinline__ bool next(int i, Unit& u) const { return pg8::dense_next(nM, nN, G, c, i, u); }
};
template <bool SIG, bool F8_ = false> struct PInProj : DenseBase {
    static constexpr int NT = F8_ ? 8 : 16, LDA = 1024, LDB = 1024, RBA = F8_ ? 1024 : 2048, RBB = F8_ ? 1024 : 2048; static constexpr bool PERM = true, HAS_MID = false, GATHER = false, FP8 = F8_;
    bf16* O; int ldc;
    static __device__ __forceinline__ float sg(float z) { z = fmaxf(z, -30.f); return __builtin_amdgcn_rcpf(1.f + __builtin_amdgcn_exp2f(-z * LOG2E)); }
    __device__ __forceinline__ void a_off(const Unit& u, int R0, int C0, unsigned (&off)[1]) const { off[0] = (unsigned)((u.pm * 256 + R0) * RBA + C0 * 2); }
    __device__ __forceinline__ const char* a_base(const Unit&, int t) const { return A + (size_t)t * 128; }
    __device__ __forceinline__ const char* b_base(const Unit& u, int t) const { return B + (size_t)u.pn * 256 * RBB + (size_t)t * 128; }
    __device__ __forceinline__ void mid(Acc&, const Unit&, int, int, int, int, int) const {}
    __device__ __forceinline__ void epi(const Acc& acc, const Unit& u, int wr, int wc, int fr, int fq) const {
        const int row0 = u.pm * 256 + wr * 64 + fr, col0 = u.pn * 256 + wc * 32 + 8 * fq;
#pragma unroll
        for (int ai = 0; ai < 2; ++ai)
#pragma unroll
            for (int m = 0; m < 4; ++m) { bf16* rowp = O + (size_t)(row0 + ai * 128 + m * 16) * ldc + col0;
#pragma unroll
                for (int bj = 0; bj < 2; ++bj) { f32x4 v0 = acc[ai][bj][m][0], v1 = acc[ai][bj][m][1];
                    constexpr float SC = F8_ ? (1.f / 32.f) : 1.f;
                    if (SIG) {
                        unsigned q[8];
#pragma unroll
                        for (int j = 0; j < 4; ++j) { q[j] = (unsigned)fmaxf(__builtin_rintf(sg(v0[j] * SC) * 255.f), 1.f); q[4 + j] = (unsigned)fmaxf(__builtin_rintf(sg(v1[j] * SC) * 255.f), 1.f); }
                        v2u w8; w8.x = q[0] | (q[1] << 8) | (q[2] << 16) | (q[3] << 24); w8.y = q[4] | (q[5] << 8) | (q[6] << 16) | (q[7] << 24);
                        *(v2u*)((unsigned char*)O + (size_t)(row0 + ai * 128 + m * 16) * ldc + col0 + bj * 128) = w8;
                        asm volatile("" ::: "memory");
                        continue; }
                    else if (F8_) { v0 *= SC; v1 *= SC; }
                    asm volatile("" ::: "memory");
                    v4u w; w.x = cvt_pk_bf16(v0[0], v0[1]); w.y = cvt_pk_bf16(v0[2], v0[3]); w.z = cvt_pk_bf16(v1[0], v1[1]); w.w = cvt_pk_bf16(v1[2], v1[3]);
                    *(v4u*)(rowp + bj * 128) = w; } }
    }
};
struct PMerge : DenseBase {
    static constexpr int NT = 24, LDA = 1536, LDB = 1536, RBA = 3072, RBB = 3072; static constexpr bool PERM = true, HAS_MID = true, GATHER = false, FP8 = false;
    const bf16* PG; bf16* O;
    __device__ __forceinline__ void a_off(const Unit& u, int R0, int C0, unsigned (&off)[1]) const { off[0] = (unsigned)((u.pm * 256 + R0) * LDA + C0) * 2u; }
    __device__ __forceinline__ const char* a_base(const Unit&, int t) const { return A + (size_t)t * 128; }
    __device__ __forceinline__ const char* b_base(const Unit& u, int t) const { return B + (size_t)u.pn * 256 * LDB * 2 + (size_t)t * 128; }
    static __device__ __forceinline__ float ub(unsigned w, int k) { return (float)((w >> (8 * k)) & 0xffu); }
    template <int MODE> __device__ __forceinline__ void scale(Acc& acc, const Unit& u, int b, int wr, int wc, int fr, int fq) const {
        unsigned loff = (unsigned)(fr * 3072 + 8 * fq), looff = (unsigned)(fr * 1024 + 8 * fq) * 2u;
        asm volatile("" : "+v"(loff), "+v"(looff));
        const char* zbase = (const char*)PG + ((size_t)(u.pm * 256 + wr * 64) * 3072 + (size_t)b * 1024 + u.pn * 256 + wc * 32);
        char* obase = (char*)O + ((size_t)(u.pm * 256 + wr * 64) * 1024 + u.pn * 256 + wc * 32) * 2;
#pragma unroll
        for (int ai = 0; ai < 2; ++ai) {
            v2u zb[4][2], zn[4][2];
#pragma unroll
            for (int m = 0; m < 4; ++m)
#pragma unroll
                for (int bj = 0; bj < 2; ++bj) { const char* zr = zbase + (size_t)(ai * 128 + m * 16) * 3072;
                    zb[m][bj] = *(const v2u*)(zr + loff + bj * 128); if (MODE == 0) zn[m][bj] = *(const v2u*)(zr + 1024 + loff + bj * 128); }
#pragma unroll
            for (int m = 0; m < 4; ++m)
#pragma unroll
                for (int bj = 0; bj < 2; ++bj) { float f[8];
#pragma unroll
                    for (int j = 0; j < 8; ++j) { const float gb = ub(zb[m][bj][j >> 2], j & 3);
                        f[j] = MODE == 0 ? gb * __builtin_amdgcn_rcpf(ub(zn[m][bj][j >> 2], j & 3)) : gb * (1.f / 255.f); }
                    f32x4 v0 = acc[ai][bj][m][0], v1 = acc[ai][bj][m][1];
                    v0[0] *= f[0]; v0[1] *= f[1]; v0[2] *= f[2]; v0[3] *= f[3]; v1[0] *= f[4]; v1[1] *= f[5]; v1[2] *= f[6]; v1[3] *= f[7];
                    if (MODE == 0) { acc[ai][bj][m][0] = v0; acc[ai][bj][m][1] = v1; }
                    else { v4u w; w.x = cvt_pk_bf16(v0[0], v0[1]); w.y = cvt_pk_bf16(v0[2], v0[3]); w.z = cvt_pk_bf16(v1[0], v1[1]); w.w = cvt_pk_bf16(v1[2], v1[3]);
                        *(v4u*)(obase + (size_t)(ai * 128 + m * 16) * 1024 * 2 + looff + bj * 256) = w; } }
            asm volatile("" ::: "memory"); }
    }
    __device__ __forceinline__ void mid(Acc& acc, const Unit& u, int t, int wr, int wc, int fr, int fq) const {
        if (t == 8 || t == 16) scale<0>(acc, u, t == 8 ? 0 : 1, wr, wc, fr, fq);
    }
    __device__ __forceinline__ void epi(Acc& acc, const Unit& u, int wr, int wc, int fr, int fq) const { scale<1>(acc, u, 2, wr, wc, fr, fq); }
};
struct POut : DenseBase {
    static constexpr int NT = 16, LDA = 1024, LDB = 1024, RBA = 2048, RBB = 2048; static constexpr bool PERM = false, HAS_MID = false, GATHER = false, FP8 = false;
    const float* base; float* X;
    __device__ __forceinline__ void a_off(const Unit& u, int R0, int C0, unsigned (&off)[1]) const { off[0] = (unsigned)((u.pm * 256 + R0) * LDA + C0) * 2u; }
    __device__ __forceinline__ const char* a_base(const Unit&, int t) const { return A + (size_t)t * 128; }
    __device__ __forceinline__ const char* b_base(const Unit& u, int t) const { return B + (size_t)u.pn * 256 * LDB * 2 + (size_t)t * 128; }
    __device__ __forceinline__ void mid(Acc&, const Unit&, int, int, int, int, int) const {}
    __device__ __forceinline__ void epi(const Acc& acc, const Unit& u, int wr, int wc, int fr, int fq) const {
        const int row0 = u.pm * 256 + wr * 64 + fr, col0 = u.pn * 256 + wc * 32 + 4 * fq;
#pragma unroll
        for (int ai = 0; ai < 2; ++ai) {
            f32x4 bv[4][2][2];
#pragma unroll
            for (int m = 0; m < 4; ++m) { const size_t o = (size_t)(row0 + ai * 128 + m * 16) * 1024 + col0;
#pragma unroll
                for (int bj = 0; bj < 2; ++bj)
#pragma unroll
                    for (int n = 0; n < 2; ++n) bv[m][bj][n] = *(const f32x4*)(base + o + bj * 128 + n * 16); }
#pragma unroll
            for (int m = 0; m < 4; ++m) { const size_t o = (size_t)(row0 + ai * 128 + m * 16) * 1024 + col0;
#pragma unroll
                for (int bj = 0; bj < 2; ++bj)
#pragma unroll
                    for (int n = 0; n < 2; ++n) *(f32x4*)(X + o + bj * 128 + n * 16) = bv[m][bj][n] + acc[ai][bj][m][n]; }
            asm volatile("" ::: "memory"); }
    }
};
struct MoeBase {
    const volatile LAS int* tp; const int* list; const float* tw; int ncol, G, c;
    __device__ __forceinline__ bool next(int i, Unit& u) const {
        const int ntr = tp[24]; const long L = (long)i * G + c; if (L >= (long)ntr * ncol) return false;
        const int rt = (int)(L / ncol); u.pn = (int)(L % ncol); u.pm = rt;
        int q = 0;
#pragma unroll 1
        for (int j = 1; j < 24; ++j) if (tp[j] <= rt) q = j;
        u.q = q; const int lt = rt - tp[q]; const int cq = tp[32 + q]; u.cnt = (cq - lt * 256) < 256 ? (cq - lt * 256) : 256; return true;
    }
    static __device__ __forceinline__ void experts(int q, int& e1, int& e2) { const int g = q / 6, pr = q % 6; const int lo = pr < 3 ? 0 : (pr < 5 ? 1 : 2); const int hi = pr < 3 ? pr + 1 : (pr < 5 ? pr - 1 : 3); e1 = g * 4 + lo; e2 = g * 4 + hi; }
    __device__ __forceinline__ int token_of(const Unit& u, int r) const { const int lt = u.pm - tp[u.q]; return list[u.q * LISTCAP + lt * 256 + r]; }
};
struct PGateUp : MoeBase {
    static constexpr int NT = 8, RBA = 1024, RBB = 1024; static constexpr bool PERM = true, HAS_MID = false, GATHER = true, FP8 = true;
    const char* A; const char* W; unsigned char* hid;
    __device__ __forceinline__ void a_off(const Unit& u, int R0, int C0, unsigned (&off)[4]) const {
#pragma unroll
        for (int j = 0; j < 4; ++j) { const int r = j * 64 + R0; const int tok = r < u.cnt ? token_of(u, r) : 0; off[j] = (unsigned)(tok * 1024 + C0 * 2); } }
    __device__ __forceinline__ const char* a_base(const Unit&, int t) const { return A + (size_t)t * 128; }
    __device__ __forceinline__ const char* b_base(const Unit& u, int t) const { int e1, e2; experts(u.q, e1, e2); const int e = (u.pn >> 2) ? e2 : e1;
        return W + ((size_t)e * 1024 + (size_t)(u.pn & 3) * 256) * 1024 + (size_t)t * 128; }
    __device__ __forceinline__ void mid(Acc&, const Unit&, int, int, int, int, int) const {}
    __device__ __forceinline__ void epi(const Acc& acc, const Unit& u, int wr, int wc, int fr, int fq) const {
        const int s = u.pn >> 2, hc0 = s * 512 + (u.pn & 3) * 128 + wc * 16 + 4 * fq;
        float wv[2][4];
        { int tk[2][4];
#pragma unroll
          for (int ai = 0; ai < 2; ++ai)
#pragma unroll
            for (int m = 0; m < 4; ++m) { const int r = ai * 128 + wr * 64 + m * 16 + fr; tk[ai][m] = r < u.cnt ? token_of(u, r) : -1; }
#pragma unroll
          for (int ai = 0; ai < 2; ++ai)
#pragma unroll
            for (int m = 0; m < 4; ++m) wv[ai][m] = tk[ai][m] >= 0 ? tw[2 * tk[ai][m] + s] * 16.f : 0.f; }
#pragma unroll
        for (int ai = 0; ai < 2; ++ai)
#pragma unroll
            for (int m = 0; m < 4; ++m) { const int r = ai * 128 + wr * 64 + m * 16 + fr;
                const float w = wv[ai][m];
                unsigned char* rowp = hid + (size_t)(u.pm * 256 + r) * 1024 + hc0;
#pragma unroll
                for (int bj = 0; bj < 2; ++bj) { const f32x4 g = acc[ai][bj][m][0] * (1.f / 32.f), up = acc[ai][bj][m][1] * (1.f / 32.f); float o[4];
#pragma unroll
                    for (int j = 0; j < 4; ++j) { const float sg = __builtin_amdgcn_rcpf(1.f + __builtin_amdgcn_exp2f(-fminf(fmaxf(g[j], -60.f), 60.f) * LOG2E)); o[j] = g[j] * sg * up[j] * w; }
                    *(unsigned*)(rowp + bj * 64) = pk4_fp8(o[0], o[1], o[2], o[3]); } }
    }
};
struct PDown : MoeBase {
    static constexpr int NT = 8, RBA = 1024, RBB = 512; static constexpr bool PERM = false, HAS_MID = false, GATHER = false, FP8 = true;
    const char* A; const char* W; float* X; int dry;
    __device__ __forceinline__ void a_off(const Unit& u, int R0, int C0, unsigned (&off)[1]) const { off[0] = (unsigned)((u.pm * 256 + R0) * RBA + C0 * 2); }
    __device__ __forceinline__ const char* a_base(const Unit&, int t) const { return A + (size_t)t * 128; }
    __device__ __forceinline__ const char* b_base(const Unit& u, int t) const { int e1, e2; experts(u.q, e1, e2); const int e = t >= 4 ? e2 : e1;
        return W + ((size_t)e * 1024 + (size_t)u.pn * 256) * 512 + (size_t)(t & 3) * 128; }
    __device__ __forceinline__ void mid(Acc&, const Unit&, int, int, int, int, int) const {}
    __device__ __forceinline__ void epi(const Acc& acc, const Unit& u, int wr, int wc, int fr, int fq) const {
        const int col0 = u.pn * 256 + wc * 32 + 4 * fq;
#pragma unroll
        for (int ai = 0; ai < 2; ++ai) {
            int tok[4];
#pragma unroll
            for (int m = 0; m < 4; ++m) { const int r = ai * 128 + wr * 64 + m * 16 + fr; tok[m] = (r < u.cnt && !dry) ? token_of(u, r) : -1; }
            f32x4 bv[4][2][2];
#pragma unroll
            for (int m = 0; m < 4; ++m) if (tok[m] >= 0) { const float* xr = X + (size_t)tok[m] * 1024 + col0;
#pragma unroll
                for (int bj = 0; bj < 2; ++bj)
#pragma unroll
                    for (int n = 0; n < 2; ++n) bv[m][bj][n] = *(const f32x4*)(xr + bj * 128 + n * 16); }
#pragma unroll
            for (int m = 0; m < 4; ++m) if (tok[m] >= 0) { float* xr = X + (size_t)tok[m] * 1024 + col0;
#pragma unroll
                for (int bj = 0; bj < 2; ++bj)
#pragma unroll
                    for (int n = 0; n < 2; ++n) *(f32x4*)(xr + bj * 128 + n * 16) = bv[m][bj][n] + acc[ai][bj][m][n] * (1.f / 256.f); }
            asm volatile("" ::: "memory"); }
    }
};

struct Frame {
    LAS unsigned char* lds; volatile LAS unsigned* MISC; unsigned* ctl;
    int tid, lane, wave, vcu, G;
};
template <int GU> __device__ __forceinline__ void transpose_item(const float* W, int K, int N, bf16* WT, int ldk, int dst_row0, int dst_col0, LAS float* scr, int item, int lane, float sc = 1.f) {
    const int nblk = N / 32, kb = item / nblk, nb = item % nblk, k0 = 64 * kb, n0 = 32 * nb;
    { float tmp_[32];
#pragma unroll
      for (int i = 0; i < 32; ++i) tmp_[i] = W[(size_t)(k0 + 2 * i + (lane >> 5)) * N + n0 + (lane & 31)];
#pragma unroll
      for (int i = 0; i < 32; ++i) scr[(2 * i + (lane >> 5)) * 33 + (lane & 31)] = tmp_[i] * sc; }
    LDS_WAIT(); asm volatile("" ::: "memory");
    const int c = lane & 7;
#pragma unroll
    for (int j = 0; j < 4; ++j) { const int n = (lane >> 3) + 8 * j; const LAS float* s = scr + (8 * c) * 33 + n;
        v4u o; o.x = pk2(s[0 * 33], s[1 * 33]); o.y = pk2(s[2 * 33], s[3 * 33]); o.z = pk2(s[4 * 33], s[5 * 33]); o.w = pk2(s[6 * 33], s[7 * 33]);
        int drow;
        if (GU == 0) drow = dst_row0 + n0 + n;
        else { const int jj = n0 + n; drow = dst_row0 + 8 * (jj >> 2) + (jj & 3); }
        *(v4u*)(WT + (size_t)drow * ldk + dst_col0 + k0 + 8 * c) = o; }
    LDS_WAIT(); asm volatile("" ::: "memory");
}
template <int GU> __device__ __forceinline__ void transpose_item8(const float* W, int K, int N, unsigned char* WT, int ldk, int dst_row0, int dst_col0, float sc, LAS float* scr, int item, int lane) {
    const int nblk = N / 32, kb = item / nblk, nb = item % nblk, k0 = 64 * kb, n0 = 32 * nb;
    { float tmp_[32];
#pragma unroll
      for (int i = 0; i < 32; ++i) tmp_[i] = W[(size_t)(k0 + 2 * i + (lane >> 5)) * N + n0 + (lane & 31)];
#pragma unroll
      for (int i = 0; i < 32; ++i) scr[(2 * i + (lane >> 5)) * 33 + (lane & 31)] = tmp_[i]; }
    LDS_WAIT(); asm volatile("" ::: "memory");
    const int n = lane >> 1, kh = (lane & 1) * 32; const LAS float* sp = scr + kh * 33 + n;
    v4u o0, o1;
#pragma unroll
    for (int j = 0; j < 4; ++j) { o0[j] = pk4_fp8(sp[(4 * j) * 33] * sc, sp[(4 * j + 1) * 33] * sc, sp[(4 * j + 2) * 33] * sc, sp[(4 * j + 3) * 33] * sc);
        o1[j] = pk4_fp8(sp[(16 + 4 * j) * 33] * sc, sp[(16 + 4 * j + 1) * 33] * sc, sp[(16 + 4 * j + 2) * 33] * sc, sp[(16 + 4 * j + 3) * 33] * sc); }
    int drow;
    if (GU == 0) drow = dst_row0 + n0 + n; else { const int jj = n0 + n; drow = dst_row0 + 8 * (jj >> 2) + (jj & 3); }
    unsigned char* dp = WT + (size_t)drow * ldk + dst_col0 + k0 + kh;
    *(v4u*)dp = o0; *(v4u*)(dp + 16) = o1;
    LDS_WAIT(); asm volatile("" ::: "memory");
}
__device__ __forceinline__ void convert_mixer_weights(Frame& F, const Args& a, int layer) {
    LAS float* scr = (LAS float*)(F.lds + F.wave * 16384);
    const int gw = F.vcu * NWAVES + F.wave, NGW = F.G * NWAVES;
    const float* w_in = a.in[3] + (size_t)layer * 1024 * D_IN; const float* w_br = a.in[10] + (size_t)layer * 3 * 512 * 1024; const float* w_out = a.in[11] + (size_t)layer * 1024 * 1024;
    bf16* WIN = (bf16*)(a.ws + WS_WIN); bf16* WBR = (bf16*)(a.ws + WS_WBR); bf16* WOUT = (bf16*)(a.ws + WS_WOUT);
    constexpr int I_IN = 16 * (D_IN / 32), I_BR = 8 * 32, I_OUT = 16 * 32;
    for (int it = gw; it < I_IN + 3 * I_BR + I_OUT; it += NGW) {
        int r = it;
        if (r < I_IN) { const int n0 = 32 * (r % (D_IN / 32));
            int d0; if (n0 < 1536) d0 = n0; else if (n0 < 6144) d0 = n0 - 1536 + 2560; else if (n0 < 7168) d0 = n0 - 6144 + 1536; else d0 = n0;
            const int f8r = n0 >= 7168 ? -7168 : (n0 >= 4608 && n0 < 6144) ? 0 : 1;
            if (f8r != 1) transpose_item8<0>(w_in, 1024, D_IN, (unsigned char*)WIN + (size_t)(N_AC + N_B) * 1024 * 2, 1024, f8r, 0, 32.f, scr, r, F.lane);
            else transpose_item<0>(w_in, 1024, D_IN, WIN, 1024, d0 - n0, 0, scr, r, F.lane, n0 < 512 ? da_QSC : 1.f);
            continue; }
        r -= I_IN;
        if (r < 3 * I_BR) { const int b = r / I_BR; transpose_item<0>(w_br + (size_t)b * 512 * 1024, 512, 1024, WBR, 1536, 0, b * 512, scr, r % I_BR, F.lane); continue; }
        r -= 3 * I_BR;
        transpose_item<0>(w_out, 1024, 1024, WOUT, 1024, 0, 0, scr, r, F.lane);
    }
}
__device__ __forceinline__ void convert_expert_weights(Frame& F, const Args& a, int layer) {
    LAS float* scr = (LAS float*)(F.lds + F.wave * 16384);
    const int gw = F.vcu * NWAVES + F.wave, NGW = F.G * NWAVES;
    const float* wg = a.in[17] + (size_t)layer * NEXP * 1024 * 512; const float* wu = a.in[18] + (size_t)layer * NEXP * 1024 * 512; const float* wd = a.in[19] + (size_t)layer * NEXP * 512 * 1024;
    bf16* WGU = (bf16*)(a.ws + WS_WGU); bf16* WD = (bf16*)(a.ws + WS_WD);
    constexpr int I_G = 16 * 16, I_D = 8 * 32;
    for (int it = gw; it < NEXP * (2 * I_G + I_D); it += NGW) {
        const int e = it / (2 * I_G + I_D); int r = it % (2 * I_G + I_D);
        if (r < I_G) { transpose_item8<1>(wg + (size_t)e * 1024 * 512, 1024, 512, (unsigned char*)WGU, 1024, e * 1024, 0, 32.f, scr, r, F.lane); continue; }
        r -= I_G;
        if (r < I_G) { transpose_item8<1>(wu + (size_t)e * 1024 * 512, 1024, 512, (unsigned char*)WGU, 1024, e * 1024 + 4, 0, 32.f, scr, r, F.lane); continue; }
        r -= I_G;
        transpose_item8<0>(wd + (size_t)e * 512 * 1024, 512, 1024, (unsigned char*)WD, 512, e * 1024, 0, 16.f, scr, r, F.lane);
    }
}
__device__ __forceinline__ int t5_bucket(int rel) {
    const int ret = rel > 0 ? 16 : 0; const int n = rel < 0 ? -rel : rel;
    if (n < 8) return ret + n;
    if (n >= 91) return ret + 15;
    unsigned long long p = (unsigned long long)n; p = p * p; p = p * p; p = p * p;
    const int lg = 63 - __builtin_clzll(p); int j = (lg - 24) >> 2; j = j > 7 ? 7 : j;
    return ret + 8 + j;
}
__device__ __forceinline__ void build_bias_tables(Frame& F, const Args& a) {
    const float* rb = a.in[1]; float* bta = (float*)(a.ws + WS_BTA); float* btb = (float*)(a.ws + WS_BTB);
    const int gt = F.vcu * 512 + F.tid, NT_ = F.G * 512;
    for (int i = gt; i < 4 * 8192; i += NT_) { const int h = i >> 13, idx = i & 8191; const int rel = idx - 4095; bta[i] = rb[t5_bucket(rel) * 28 + h]; }
    { const float* sw = a.in[8]; bf16* sgw = (bf16*)(a.ws + WS_SGW); for (int i = gt; i < 2 * 4 * 128 * 128; i += NT_) sgw[i] = (bf16)f2bf(sw[i]); }
    for (int i = gt; i < 3 * 8 * 192; i += NT_) { const int g = i / (8 * 192), hh = (i / 192) % 8, idx = i % 192; const int r = g == 0 ? 1 : (g == 1 ? 4 : 16);
        const int rel = idx - 96; btb[i] = (rel >= -64 && rel <= 64) ? rb[t5_bucket(rel * r) * 28 + 4 + g * 8 + hh] * 8.f : -1e30f; }
}
__device__ __forceinline__ void rms_row_to_bf16(const float* xrow, const float* g, bf16* orow, unsigned* orow8, int lane) {
    const f32x4* xr = (const f32x4*)xrow + lane; f32x4 v[4]; float s = 0.f;
#pragma unroll
    for (int j = 0; j < 4; ++j) { v[j] = xr[64 * j]; s += (v[j].x * v[j].x + v[j].y * v[j].y) + (v[j].z * v[j].z + v[j].w * v[j].w); }
    const float rstd = 1.f / sqrtf(wave_sum(s) * (1.f / DM) + EPS);
    unsigned long long* o8 = (unsigned long long*)orow + lane;
#pragma unroll
    for (int j = 0; j < 4; ++j) { const f32x4 gg = ((const f32x4*)g)[lane + 64 * j]; const f32x4 t = v[j] * rstd * gg;
        o8[64 * j] = (unsigned long long)pk2(t.x, t.y) | ((unsigned long long)pk2(t.z, t.w) << 32);
        orow8[lane + 64 * j] = pk4_fp8(t.x, t.y, t.z, t.w); }
}
__device__ __forceinline__ void phase_norm(Frame& F, const float* X, const float* g, bf16* H, unsigned char* H8) {
    const int gw = F.vcu * NWAVES + F.wave, NGW = F.G * NWAVES;
    const int lane = F.lane; f32x4 va[4], vb[4], vc[4];
    { const f32x4* x0 = (const f32x4*)(X + (size_t)gw * DM) + lane; const f32x4* x1 = (const f32x4*)(X + (size_t)(gw + NGW < T ? gw + NGW : gw) * DM) + lane;
#pragma unroll
      for (int j = 0; j < 4; ++j) { va[j] = x0[64 * j]; vb[j] = x1[64 * j]; } }
#pragma unroll 1
    for (int m = gw; m < T; m += NGW) {
        { const int m2 = m + 2 * NGW; const f32x4* x2 = (const f32x4*)(X + (size_t)(m2 < T ? m2 : m) * DM) + lane;
#pragma unroll
          for (int j = 0; j < 4; ++j) vc[j] = x2[64 * j]; }
        float s = 0.f;
#pragma unroll
        for (int j = 0; j < 4; ++j) s += (va[j].x * va[j].x + va[j].y * va[j].y) + (va[j].z * va[j].z + va[j].w * va[j].w);
        const float rstd = 1.f / sqrtf(wave_sum(s) * (1.f / DM) + EPS);
        unsigned long long* o8 = (unsigned long long*)(H + (size_t)m * DM) + lane; unsigned* q8 = (unsigned*)(H8 + (size_t)m * DM) + lane;
#pragma unroll
        for (int j = 0; j < 4; ++j) { const f32x4 gg = ((const f32x4*)g)[lane + 64 * j]; const f32x4 t = va[j] * rstd * gg;
            o8[64 * j] = (unsigned long long)pk2(t.x, t.y) | ((unsigned long long)pk2(t.z, t.w) << 32);
            q8[64 * j] = pk4_fp8(t.x, t.y, t.z, t.w); }
#pragma unroll
        for (int j = 0; j < 4; ++j) { va[j] = vb[j]; vb[j] = vc[j]; }
    }
}
__device__ __forceinline__ void phase_final_norm(Frame& F, float* X, const float* g) {
    const int gw = F.vcu * NWAVES + F.wave, NGW = F.G * NWAVES, lane = F.lane;
#pragma unroll 1
    for (int m0 = gw; m0 < T; m0 += 4 * NGW) {
        f32x4 v[4][4];
#pragma unroll
        for (int u = 0; u < 4; ++u) { const int m = m0 + u * NGW < T ? m0 + u * NGW : m0; const f32x4* xr = (const f32x4*)(X + (size_t)m * DM) + lane;
#pragma unroll
            for (int j = 0; j < 4; ++j) v[u][j] = xr[64 * j]; }
#pragma unroll
        for (int u = 0; u < 4; ++u) { const int m = m0 + u * NGW; if (m >= T) break;
            float s = 0.f;
#pragma unroll
            for (int j = 0; j < 4; ++j) s += (v[u][j].x * v[u][j].x + v[u][j].y * v[u][j].y) + (v[u][j].z * v[u][j].z + v[u][j].w * v[u][j].w);
            const float rstd = 1.f / sqrtf(wave_sum(s) * (1.f / DM) + EPS);
            f32x4* xw = (f32x4*)(X + (size_t)m * DM) + lane;
#pragma unroll
            for (int j = 0; j < 4; ++j) { const f32x4 gg = ((const f32x4*)g)[lane + 64 * j]; xw[64 * j] = v[u][j] * rstd * gg; } }
    }
}
__device__ __forceinline__ void phase_router(Frame& F, const Args& a, int layer, const float* X, bf16* H) {
    const int lane = F.lane, wid = F.wave, tid = F.tid;
    const float* g = a.in[12] + (size_t)layer * DM;
    const float* wrg = a.in[13] + (size_t)layer * DM * 4; const float* brg = a.in[14] + layer * 4;
    const float* wre = a.in[15] + (size_t)layer * 4 * DM * 4; const float* bre = a.in[16] + layer * 16;
    int* list = (int*)(a.ws + WS_LIST); float* tw = (float*)(a.ws + WS_TW); unsigned* cnt = F.ctl + CW_CNT + layer * 32;
    LAS f32x4* tab = (LAS f32x4*)F.lds;
    LAS int* tq = (LAS int*)(F.lds + 81920); LAS int* trank = tq + 128; LAS float* twl = (LAS float*)(trank + 128); LAS int* lcnt = (LAS int*)(twl + 256); LAS int* lbase = lcnt + 32; LAS float* lbias = (LAS float*)(lbase + 32);
    if (tid < 20) lbias[tid] = tid < 4 ? brg[tid] : bre[tid - 4];
    { f32x4 wv_[10]; float gv_[10];
#pragma unroll
      for (int k = 0; k < 10; ++k) { const int i = tid + 512 * k; const int q = i >> 10, jj = (i >> 6) & 15, l = i & 63; const int d = 4 * (l + 64 * (jj >> 2)) + (jj & 3);
        wv_[k] = q == 0 ? *(const f32x4*)(wrg + (size_t)d * 4) : *(const f32x4*)(wre + ((size_t)(q - 1) * DM + d) * 4); gv_[k] = g[d]; }
#pragma unroll
      for (int k = 0; k < 10; ++k) tab[tid + 512 * k] = wv_[k] * gv_[k]; }
    for (int blk = F.vcu; blk < T / 128; blk += F.G) {
        if (tid < 32) lcnt[tid] = 0;
        __syncthreads();
        f32x4 vq[4][4];
#pragma unroll
        for (int u = 0; u < 4; ++u) { const f32x4* xr = (const f32x4*)(X + (size_t)(blk * 128 + wid * 16 + u) * DM) + lane;
#pragma unroll
          for (int j = 0; j < 4; ++j) vq[u][j] = xr[64 * j]; }
#pragma unroll 1
        for (int i0 = 0; i0 < 16; i0 += 4) {
        { constexpr int up = 0;
            f32x4 v[4][4]; float rstd[4]; int mt[4];
#pragma unroll
            for (int t = 0; t < 4; ++t) { const int i = i0 + up + t; mt[t] = blk * 128 + wid * 16 + i;
#pragma unroll
                for (int j = 0; j < 4; ++j) v[t][j] = vq[up + t][j];
                const f32x4* xr = (const f32x4*)(X + (size_t)(i < 12 ? mt[t] + 4 : mt[t]) * DM) + lane;
#pragma unroll
                for (int j = 0; j < 4; ++j) vq[up + t][j] = xr[64 * j]; }
            { float ss_[4];
#pragma unroll
              for (int t = 0; t < 4; ++t) { ss_[t] = 0.f;
#pragma unroll
                for (int j = 0; j < 4; ++j) ss_[t] += (v[t][j].x * v[t][j].x + v[t][j].y * v[t][j].y) + (v[t][j].z * v[t][j].z + v[t][j].w * v[t][j].w); }
#pragma unroll
              for (int t = 0; t < 4; ++t) ss_[t] = wave_sum(ss_[t]);
#pragma unroll
              for (int t = 0; t < 4; ++t) rstd[t] = 1.f / sqrtf(ss_[t] * (1.f / DM) + EPS); }
#pragma unroll
            for (int t = 0; t < 4; ++t) { unsigned* o8 = (unsigned*)((unsigned char*)H + (size_t)mt[t] * DM) + lane;
#pragma unroll
                for (int j = 0; j < 4; ++j) { const f32x4 gg = ((const f32x4*)g)[lane + 64 * j]; const f32x4 tt = v[t][j] * rstd[t] * gg; o8[64 * j] = pk4_fp8(tt.x, tt.y, tt.z, tt.w); } }
            f32x4 lg[4];
#pragma unroll
            for (int t = 0; t < 4; ++t) lg[t] = f32x4{0.f, 0.f, 0.f, 0.f};
#pragma unroll
            for (int jj = 0; jj < 16; ++jj) { const f32x4 w = tab[jj * 64 + lane];
#pragma unroll
                for (int t = 0; t < 4; ++t) lg[t] += v[t][jj >> 2][jj & 3] * w; }
#pragma unroll
            for (int t = 0; t < 4; ++t) { lg[t].x = wave_sum(lg[t].x); lg[t].y = wave_sum(lg[t].y); lg[t].z = wave_sum(lg[t].z); lg[t].w = wave_sum(lg[t].w); }
            int gi[4]; float gwt[4];
#pragma unroll
            for (int t = 0; t < 4; ++t) { const f32x4 gl = lg[t] * rstd[t] + *(const LAS f32x4*)lbias;
                int gi_ = 0; float gm = gl.x;
                if (gl.y > gm) { gm = gl.y; gi_ = 1; }
                if (gl.z > gm) { gm = gl.z; gi_ = 2; }
                if (gl.w > gm) { gm = gl.w; gi_ = 3; }
                const float den = __expf(gl.x - gm) + __expf(gl.y - gm) + __expf(gl.z - gm) + __expf(gl.w - gm);
                gwt[t] = 1.f / den; gi[t] = __builtin_amdgcn_readfirstlane(gi_); }
            f32x4 le[4];
#pragma unroll
            for (int t = 0; t < 4; ++t) le[t] = f32x4{0.f, 0.f, 0.f, 0.f};
#pragma unroll
            for (int jj = 0; jj < 16; ++jj) {
#pragma unroll
                for (int t = 0; t < 4; ++t) le[t] += v[t][jj >> 2][jj & 3] * tab[(1 + gi[t]) * 1024 + jj * 64 + lane]; }
#pragma unroll
            for (int t = 0; t < 4; ++t) { le[t].x = wave_sum(le[t].x); le[t].y = wave_sum(le[t].y); le[t].z = wave_sum(le[t].z); le[t].w = wave_sum(le[t].w); }
            int qq[4]; float wl_[4], wh_[4];
#pragma unroll
            for (int t = 0; t < 4; ++t) { const f32x4 el = le[t] * rstd[t] + *(const LAS f32x4*)(lbias + 4 + gi[t] * 4);
                int i1 = 0; float v1 = el.x;
                if (el.y > v1) { v1 = el.y; i1 = 1; }
                if (el.z > v1) { v1 = el.z; i1 = 2; }
                if (el.w > v1) { v1 = el.w; i1 = 3; }
                int i2 = -1; float v2 = -3.0e38f;
                if (i1 != 0 && el.x > v2) { v2 = el.x; i2 = 0; }
                if (i1 != 1 && el.y > v2) { v2 = el.y; i2 = 1; }
                if (i1 != 2 && el.z > v2) { v2 = el.z; i2 = 2; }
                if (i1 != 3 && el.w > v2) { v2 = el.w; i2 = 3; }
                const float e2 = __expf(v2 - v1); const float w1 = gwt[t] / (1.f + e2), w2 = gwt[t] * e2 / (1.f + e2);
                const int lo = i1 < i2 ? i1 : i2, hi = i1 < i2 ? i2 : i1; wl_[t] = i1 < i2 ? w1 : w2; wh_[t] = i1 < i2 ? w2 : w1;
                const int pr = lo == 0 ? hi - 1 : (lo == 1 ? hi + 1 : 5); qq[t] = gi[t] * 6 + pr; }
            if (lane == 0) {
#pragma unroll
                for (int t = 0; t < 4; ++t) { const int k = wid * 16 + i0 + up + t; tq[k] = qq[t]; trank[k] = __hip_atomic_fetch_add(&lcnt[qq[t]], 1, __ATOMIC_RELAXED, __HIP_MEMORY_SCOPE_WORKGROUP); twl[2 * k] = wl_[t]; twl[2 * k + 1] = wh_[t]; } }
        } }
        __syncthreads();
        if (tid < NBUCKET && !a.dry) lbase[tid] = (int)atomicAdd(&cnt[tid], (unsigned)lcnt[tid]);
        __syncthreads();
        if (tid < 128 && !a.dry) { const int m = blk * 128 + tid, q = tq[tid]; list[q * LISTCAP + lbase[q] + trank[tid]] = m; tw[2 * m] = twl[2 * tid]; tw[2 * m + 1] = twl[2 * tid + 1]; }
        __syncthreads();
    }
}
__device__ __forceinline__ void moe_table(Frame& F, int layer) {
    if (F.tid == 0) { volatile LAS int* tp = (volatile LAS int*)(F.MISC + 16); int acc = 0;
        for (int q = 0; q < 24; ++q) { const int c = (int)__hip_atomic_load(F.ctl + CW_CNT + layer * 32 + q, __ATOMIC_RELAXED, __HIP_MEMORY_SCOPE_AGENT); tp[q] = acc; tp[32 + q] = c; acc += (c + 255) >> 8; }
        tp[24] = acc; }
    __syncthreads();
}

__device__ __forceinline__ void phase_attnA_naive(Frame& F, const Args& a) {
    const bf16* PAC = (const bf16*)(a.ws + WS_P); float* OA = (float*)(a.ws + WS_OA); const float* bta = (const float*)(a.ws + WS_BTA);
    LAS float* Ks = (LAS float*)F.lds; LAS float* Vs = Ks + 64 * 64;
    for (int unit = F.vcu; unit < 8 * 4 * 2 * 8; unit += F.G) {
        const int qc = unit & 7, c = (unit >> 3) & 1, h = (unit >> 4) & 3, b = unit >> 6;
        const int qpos = qc * 512 + F.tid; const size_t tok = (size_t)b * SEQ + qpos;
        float q[64], o[128];
        { const bf16* qp = PAC + tok * N_AC + h * 128 + c * 64;
#pragma unroll
          for (int d = 0; d < 64; d += 8) { const v4u w = *(const v4u*)(qp + d);
#pragma unroll
              for (int j = 0; j < 4; ++j) { q[d + 2 * j] = bflo(w[j]) * 0.125f; q[d + 2 * j + 1] = bfhi(w[j]) * 0.125f; } } }
#pragma unroll
        for (int e = 0; e < 128; ++e) o[e] = 0.f;
        float mx = -1e30f, l = 0.f;
        const float* bt = bta + h * 8192 + 4095 - qpos;
        for (int kt = 0; kt < 64; ++kt) {
            __syncthreads();
            { const int key = F.tid >> 3, ch = F.tid & 7; const size_t kr = ((size_t)b * SEQ + kt * 64 + key) * N_AC;
              const v4u w = *(const v4u*)(PAC + kr + 512 + h * 128 + c * 64 + ch * 8);
#pragma unroll
              for (int j = 0; j < 4; ++j) { Ks[key * 64 + ch * 8 + 2 * j] = bflo(w[j]); Ks[key * 64 + ch * 8 + 2 * j + 1] = bfhi(w[j]); }
#pragma unroll
              for (int hh = 0; hh < 2; ++hh) { const v4u u = *(const v4u*)(PAC + kr + 1024 + h * 128 + hh * 64 + ch * 8);
#pragma unroll
                  for (int j = 0; j < 4; ++j) { Vs[key * 128 + hh * 64 + ch * 8 + 2 * j] = bflo(u[j]); Vs[key * 128 + hh * 64 + ch * 8 + 2 * j + 1] = bfhi(u[j]); } } }
            __syncthreads();
#pragma unroll 1
            for (int j = 0; j < 64; ++j) {
                float s = 0.f;
#pragma unroll
                for (int d = 0; d < 64; d += 4) { const f32x4 kv = *(const LAS f32x4*)(Ks + j * 64 + d); s += q[d] * kv.x + q[d + 1] * kv.y + q[d + 2] * kv.z + q[d + 3] * kv.w; }
                s += bt[kt * 64 + j];
                if (s > mx) { const float f = __expf(mx - s); l *= f;
#pragma unroll
                    for (int e = 0; e < 128; ++e) o[e] *= f;
                    mx = s; }
                const float pw = __expf(s - mx); l += pw;
#pragma unroll
                for (int e = 0; e < 128; e += 4) { const f32x4 vv = *(const LAS f32x4*)(Vs + j * 128 + e); o[e] += pw * vv.x; o[e + 1] += pw * vv.y; o[e + 2] += pw * vv.z; o[e + 3] += pw * vv.w; }
            }
        }
        const float il = 1.f / l; float* op = OA + ((size_t)c * T + tok) * 512 + h * 128;
#pragma unroll
        for (int e = 0; e < 128; e += 4) *(f32x4*)(op + e) = (f32x4){o[e] * il, o[e + 1] * il, o[e + 2] * il, o[e + 3] * il};
    }
    __syncthreads();
}
__device__ __forceinline__ void phase_attnA_combine(Frame& F, const Args& a, int layer) {
    const float* OA = (const float*)(a.ws + WS_OA); bf16* Y = (bf16*)(a.ws + WS_Y);
    const float* lp = a.in[4] + layer * 256; const float* sg = a.in[5] + layer * 128;
    const float lam_init = 0.8f - 0.6f * expf(-0.3f * (float)layer);
    const float s01 = wave_sum(lp[F.lane] * lp[64 + F.lane]), s23 = wave_sum(lp[128 + F.lane] * lp[192 + F.lane]);
    const float lam = expf(s01) - expf(s23) + lam_init;
    const int gw = F.vcu * NWAVES + F.wave, NGW = F.G * NWAVES, lane = F.lane;
    for (int m = gw; m < T; m += NGW) {
        const f32x4* p0 = (const f32x4*)(OA + (size_t)m * 512 + lane * 8); const f32x4* p1 = (const f32x4*)(OA + ((size_t)T + m) * 512 + lane * 8);
        float y[8]; { const f32x4 a0 = p0[0], a1 = p0[1], b0 = p1[0], b1 = p1[1];
#pragma unroll
            for (int j = 0; j < 4; ++j) { y[j] = a0[j] - lam * b0[j]; y[4 + j] = a1[j] - lam * b1[j]; } }
        float ss = 0.f;
#pragma unroll
        for (int j = 0; j < 8; ++j) ss += y[j] * y[j];
        ss += __shfl_xor(ss, 1); ss += __shfl_xor(ss, 2); ss += __shfl_xor(ss, 4); ss += __shfl_xor(ss, 8);
        const float r = (1.f / sqrtf(ss * (1.f / 128.f) + EPS)) * (1.f - lam_init);
        const int e0 = (lane & 15) * 8; v4u w;
        w.x = pk2(y[0] * r * sg[e0], y[1] * r * sg[e0 + 1]); w.y = pk2(y[2] * r * sg[e0 + 2], y[3] * r * sg[e0 + 3]);
        w.z = pk2(y[4] * r * sg[e0 + 4], y[5] * r * sg[e0 + 5]); w.w = pk2(y[6] * r * sg[e0 + 6], y[7] * r * sg[e0 + 7]);
        *(v4u*)(Y + (size_t)m * 1536 + lane * 8) = w;
    }
}
namespace da {
constexpr int SHM_V = 64 * 128 * 2, SHM_K = 64 * 64 * 2;
constexpr int NSLOT = 5, LDS_V = 0, LDS_K = NSLOT * SHM_V, LDS_WS = LDS_K + NSLOT * SHM_K, LDS_TAB = LDS_WS + NWAVES * 64 * 4, TABP = 452, LDS_END = LDS_TAB + 4 * TABP * 4;
constexpr float C2 = 1.f;
constexpr float THR2 = 8.f * LOG2E;
#define KSWZ64(row, colB) ((row) * 128 + ((colB) ^ ((((row) >> 1) & 7) << 4)))
#define SBAR() __builtin_amdgcn_sched_barrier(0)
template <int VAR> __device__ __forceinline__ void partialSM(f32x16& p0, f32x16& p1, float& m_reg, float& alpha, float cst) {
    float pmax = p0[0];
#pragma unroll
    for (int r = 1; r < 16; ++r) pmax = fmaxf(pmax, p0[r]);
#pragma unroll
    for (int r = 0; r < 16; ++r) pmax = fmaxf(pmax, p1[r]);
    { auto rr = __builtin_amdgcn_permlane32_swap(__float_as_uint(pmax), __float_as_uint(pmax), false, false); pmax = fmaxf(__uint_as_float(rr[0]), __uint_as_float(rr[1])); }
    pmax = fmaf(pmax, C2, cst);
    float mn;
    if (__builtin_expect(__all(pmax - m_reg <= THR2), 1)) { mn = m_reg; alpha = 1.f; }
    else { mn = fmaxf(m_reg, pmax); alpha = __builtin_amdgcn_exp2f(m_reg - mn); m_reg = mn; }
    const float off = cst - mn;
#pragma unroll
    for (int r = 0; r < 16; ++r) { p0[r] = fmaf(p0[r], C2, off); p1[r] = fmaf(p1[r], C2, off); }
    if (VAR != 3) {
#pragma unroll
    for (int r = 0; r < 16; ++r) p0[r] = __builtin_amdgcn_exp2f(p0[r]); }
}
template <int VAR> __device__ __forceinline__ void finishSM(f32x16& p0, f32x16& p1, float alpha, float& l_reg, bf16x8& pa0, bf16x8& pa1, bf16x8& pa2, bf16x8& pa3) {
    if (VAR != 3) {
#pragma unroll
    for (int r = 0; r < 16; ++r) p1[r] = __builtin_amdgcn_exp2f(p1[r]); }
    float ps = 0.f;
#pragma unroll
    for (int r = 0; r < 16; ++r) ps += p0[r];
#pragma unroll
    for (int r = 0; r < 16; ++r) ps += p1[r];
    { auto rr = __builtin_amdgcn_permlane32_swap(__float_as_uint(ps), __float_as_uint(ps), false, false); ps = __uint_as_float(rr[0]) + __uint_as_float(rr[1]); }
    l_reg = l_reg * alpha + ps;
#define PK4(P, BASE, OUT) do { unsigned a0 = cvt_pk_bf16(P[BASE + 0], P[BASE + 1]), a1 = cvt_pk_bf16(P[BASE + 2], P[BASE + 3]);   \
    unsigned b0 = cvt_pk_bf16(P[BASE + 4], P[BASE + 5]), b1 = cvt_pk_bf16(P[BASE + 6], P[BASE + 7]);                              \
    auto r0 = __builtin_amdgcn_permlane32_swap(a0, b0, false, false); auto r1 = __builtin_amdgcn_permlane32_swap(a1, b1, false, false); \
    v4u w_ = {r0[0], r1[0], r0[1], r1[1]}; OUT = __builtin_bit_cast(bf16x8, w_); } while (0)
    PK4(p0, 0, pa0); PK4(p0, 8, pa1); PK4(p1, 0, pa2); PK4(p1, 8, pa3);
#undef PK4
}
template <int VAR> __device__ __forceinline__ void qkt_load(bf16x8 (&kf)[4], const LAS unsigned char* Ks, int r32, int hi) {
#pragma unroll
    for (int d0 = 0; d0 < 2; ++d0) { const int cb = (d0 * 16 + hi * 8) * 2;
        kf[2 * d0] = *(const LAS bf16x8*)(Ks + KSWZ64(r32, cb)); kf[2 * d0 + 1] = *(const LAS bf16x8*)(Ks + KSWZ64(32 + r32, cb)); }
}
template <int VAR> __device__ __forceinline__ void qkt_mma(f32x16& p0, f32x16& p1, const bf16x8 (&kf)[4], const LAS unsigned char* Ks, const bf16x8* qr, int r32, int hi, const LAS float* tb) {
    if (VAR == 2) { p0 = f32x16{}; p1 = f32x16{}; } else {
#pragma unroll
    for (int g4 = 0; g4 < 4; ++g4) { const f32x4 a = *(const LAS f32x4*)(tb + 8 * g4), b = *(const LAS f32x4*)(tb + 32 + 8 * g4);
        p0[4 * g4] = a.x; p0[4 * g4 + 1] = a.y; p0[4 * g4 + 2] = a.z; p0[4 * g4 + 3] = a.w; p1[4 * g4] = b.x; p1[4 * g4 + 1] = b.y; p1[4 * g4 + 2] = b.z; p1[4 * g4 + 3] = b.w; } }
    bf16x8 kg[4];
#pragma unroll
    for (int d0 = 2; d0 < 4; ++d0) { const int cb = (d0 * 16 + hi * 8) * 2;
        kg[2 * d0 - 4] = *(const LAS bf16x8*)(Ks + KSWZ64(r32, cb)); kg[2 * d0 - 3] = *(const LAS bf16x8*)(Ks + KSWZ64(32 + r32, cb)); }
    if (VAR == 6) return;
#pragma unroll
    for (int d0 = 0; d0 < 2; ++d0) {
        p0 = __builtin_amdgcn_mfma_f32_32x32x16_bf16(kf[2 * d0], qr[d0], p0, 0, 0, 0);
        p1 = __builtin_amdgcn_mfma_f32_32x32x16_bf16(kf[2 * d0 + 1], qr[d0], p1, 0, 0, 0); }
#pragma unroll
    for (int d0 = 2; d0 < 4; ++d0) {
        p0 = __builtin_amdgcn_mfma_f32_32x32x16_bf16(kg[2 * d0 - 4], qr[d0], p0, 0, 0, 0);
        p1 = __builtin_amdgcn_mfma_f32_32x32x16_bf16(kg[2 * d0 - 3], qr[d0], p1, 0, 0, 0); }
}
__device__ __forceinline__ int v_st(int k, int c) { const int kk = (k & ~0xC) | ((k & 4) << 1) | ((k & 8) >> 1); return ((kk >> 3) * 4 + (c >> 5)) * 512 + ((kk & 7) * 32 + (c & 31)) * 2; }
__device__ __forceinline__ int v_rd_base(int lane) { return ((lane & 3) << 3) | (((lane >> 2) & 3) << 6) | (((lane >> 4) & 1) << 5) | (((lane >> 5) & 1) << 8); }
constexpr int v_rd_off(int d0, int ks, int half) { return d0 * 512 + ks * 4096 + half * 2048; }
template <int OFF> __device__ __forceinline__ s16x4 tr_read(int vb) { s16x4 r; asm volatile("ds_read_b64_tr_b16 %0, %1 offset:%2" : "=&v"(r) : "v"(vb), "i"(OFF) : "memory"); return r; }
template <int D0> __device__ __forceinline__ void pv_one(f32x16& od, int vb, bf16x8 pa0, bf16x8 pa1, bf16x8 pa2, bf16x8 pa3) {
    const s16x4 l0 = tr_read<v_rd_off(D0, 0, 0)>(vb), h0 = tr_read<v_rd_off(D0, 0, 1)>(vb), l1 = tr_read<v_rd_off(D0, 1, 0)>(vb), h1 = tr_read<v_rd_off(D0, 1, 1)>(vb);
    const s16x4 l2 = tr_read<v_rd_off(D0, 2, 0)>(vb), h2 = tr_read<v_rd_off(D0, 2, 1)>(vb), l3 = tr_read<v_rd_off(D0, 3, 0)>(vb), h3 = tr_read<v_rd_off(D0, 3, 1)>(vb);
    asm volatile("s_waitcnt lgkmcnt(0)" ::: "memory"); SBAR();
#define PKV(L, H) (bf16x8){L[0], L[1], L[2], L[3], H[0], H[1], H[2], H[3]}
    od = __builtin_amdgcn_mfma_f32_32x32x16_bf16(pa0, PKV(l0, h0), od, 0, 0, 0);
    od = __builtin_amdgcn_mfma_f32_32x32x16_bf16(pa1, PKV(l1, h1), od, 0, 0, 0);
    od = __builtin_amdgcn_mfma_f32_32x32x16_bf16(pa2, PKV(l2, h2), od, 0, 0, 0);
    od = __builtin_amdgcn_mfma_f32_32x32x16_bf16(pa3, PKV(l3, h3), od, 0, 0, 0);
#undef PKV
}
__device__ __forceinline__ void pv_d0(f32x16* o, int vb, bf16x8 pa0, bf16x8 pa1, bf16x8 pa2, bf16x8 pa3) {
    pv_one<0>(o[0], vb, pa0, pa1, pa2, pa3); pv_one<1>(o[1], vb, pa0, pa1, pa2, pa3); pv_one<2>(o[2], vb, pa0, pa1, pa2, pa3); pv_one<3>(o[3], vb, pa0, pa1, pa2, pa3);
}
template <int VAR> __device__ __forceinline__ void pass(const bf16* __restrict__ Qw, const bf16* __restrict__ Kh, const bf16* __restrict__ Vh, LAS unsigned char* lds, f32x16 (&o)[4], float& l_out,
                                     int tid, int wid, int lane, int r32, int hi, int qw0, float cL, float cR) {
    LAS unsigned char* V_lds = lds + LDS_V; LAS unsigned char* K_lds = lds + LDS_K;
    LAS float* al_l = (LAS float*)(lds + LDS_WS) + wid * 64 + 32;
    const LAS float* tab = (const LAS float*)(lds + LDS_TAB);
    float m_reg = -1e30f, l_reg = 0.f;
#pragma unroll
    for (int d = 0; d < 4; ++d) o[d] = f32x16{};
    bf16x8 qr[4];
#pragma unroll
    for (int d0 = 0; d0 < 4; ++d0) qr[d0] = *(const bf16x8*)(Qw + (size_t)r32 * N_AC + d0 * 16 + hi * 8);
    const int krow = wid * 8 + (lane >> 3), kcolB = ((lane & 7) * 16) ^ (((krow >> 1) & 7) << 4);
    const unsigned koff = (unsigned)(krow * N_AC) * 2u + (unsigned)kcolB;
    unsigned voff[2];
#pragma unroll
    for (int i = 0; i < 2; ++i) { const int L = i * 8192 + wid * 1024 + lane * 16, st = L >> 9, win = L & 511, kk = (st >> 2) * 8 + (win >> 6), k = (kk & ~0xC) | ((kk & 4) << 1) | ((kk & 8) >> 1), c = (st & 3) * 32 + ((win & 63) >> 1);
        voff[i] = (unsigned)(k * N_AC + c) * 2u; }
    const int vb0 = (int)(uintptr_t)V_lds + v_rd_base(lane);
#define DMA(t, slot) do { const char* kt_ = (const char*)Kh + (size_t)(t) * 64 * N_AC * 2; const char* vt_ = (const char*)Vh + (size_t)(t) * 64 * N_AC * 2; \
    __builtin_amdgcn_global_load_lds((const unsigned*)(kt_ + koff), (LAS unsigned*)(K_lds + (slot) * SHM_K + wid * 1024), 16, 0, 0); \
    __builtin_amdgcn_global_load_lds((const unsigned*)(vt_ + voff[0]), (LAS unsigned*)(V_lds + (slot) * SHM_V + wid * 1024), 16, 0, 0); \
    __builtin_amdgcn_global_load_lds((const unsigned*)(vt_ + voff[1]), (LAS unsigned*)(V_lds + (slot) * SHM_V + 8192 + wid * 1024), 16, 0, 0); } while (0)
#define WAITBAR(N) do { asm volatile("s_waitcnt vmcnt(" #N ") lgkmcnt(0)" ::: "memory"); __builtin_amdgcn_s_barrier(); asm volatile("" ::: "memory"); } while (0)
#define RESC(a) do { if (__any((a) < 1.f)) { if (hi == 0) al_l[r32] = (a); asm volatile("s_waitcnt lgkmcnt(0)" ::: "memory"); \
    _Pragma("unroll") for (int d = 0; d < 4; ++d) _Pragma("unroll") for (int r = 0; r < 16; ++r) o[d][r] *= al_l[crow(r, hi)]; } } while (0)
#define TBIDX(t) (((t) * 64 - qw0) >= 122 ? 384 : (((t) * 64 - qw0) <= -154 ? 0 : ((t) * 64 - qw0 + 224 - r32 + 4 * hi)))
#define TBASE(t) (((TBIDX(t)) & 3) * TABP + ((TBIDX(t)) & ~3))
#define QKL(slot) qkt_load<VAR>(kf, K_lds + (slot) * SHM_K, r32, hi)
#define QKM(P0, P1, slot, t) qkt_mma<VAR>(P0, P1, kf, K_lds + (slot) * SHM_K, qr, r32, hi, tab + TBASE(t))
#define PSM(P0, P1, AL) partialSM<VAR>(P0, P1, m_reg, AL, 0.f)
#define NEXT(x) ((x) == NSLOT - 1 ? 0 : (x) + 1)
    f32x16 pA0, pA1, pB0, pB1; float alA, alB; bf16x8 pa0, pa1, pa2, pa3; constexpr int NT = SEQ / 64;
    int s_m1 = 0, s_0 = 1, s_p2 = 3;
    DMA(0, 0); DMA(1, 1); WAITBAR(3);
    bf16x8 kf[4];
    QKL(0); QKM(pA0, pA1, 0, 0); PSM(pA0, pA1, alA);
    DMA(2, 2); WAITBAR(3);
    if (wid >= 4) WAITBAR(3);
#define STEP(PN0, PN1, PO0, PO1, ALN, ALO, t) do { \
        { const int tt_ = (t) + 2 < NT ? (t) + 2 : NT - 1; DMA(tt_, s_p2); } \
        SBAR(); QKL(s_0); SBAR(); \
        finishSM<VAR>(PO0, PO1, ALO, l_reg, pa0, pa1, pa2, pa3); SBAR(); \
        QKM(PN0, PN1, s_0, t); SBAR(); \
        WAITBAR(3); \
        if (VAR != 4) pv_d0(o, vb0 + s_m1 * SHM_V, pa0, pa1, pa2, pa3); PSM(PN0, PN1, ALN); \
        RESC(ALN); WAITBAR(3); \
        s_m1 = s_0; s_0 = NEXT(s_0); s_p2 = NEXT(s_p2); } while (0)
#pragma unroll 1
    for (int j = 1; j + 1 < NT; j += 2) {
        STEP(pB0, pB1, pA0, pA1, alB, alA, j);
        STEP(pA0, pA1, pB0, pB1, alA, alB, j + 1);
    }
    STEP(pB0, pB1, pA0, pA1, alB, alA, NT - 1);
    if (wid < 4) WAITBAR(3);
    finishSM<VAR>(pB0, pB1, alB, l_reg, pa0, pa1, pa2, pa3); SBAR();
    pv_d0(o, vb0 + s_m1 * SHM_V, pa0, pa1, pa2, pa3);
#undef STEP
#undef NEXT
    l_out = l_reg;
    asm volatile("s_waitcnt vmcnt(0)" ::: "memory");
    __syncthreads();
#undef DMA
#undef WAITBAR
#undef RESC
#undef PSM
#undef QKL
#undef QKM
#undef TBASE
#undef TBIDX
}

constexpr int NKS = 4, NVS = 5, P2_V = 0, P2_K = NVS * SHM_V, P2_WS = P2_K + NKS * SHM_K, P2_TAB = P2_WS + NWAVES * 64 * 4, P2_END = P2_TAB + 4 * TABP * 4;
__device__ __forceinline__ void pass2(const bf16* __restrict__ Qw, const bf16* __restrict__ Kh, const bf16* __restrict__ Vh, LAS unsigned char* lds, f32x16 (&o)[4], float& l_out,
                                      int tid_, int wid, int lane_, int r32_, int hi_, int qw0, float cL, float cR) {
    int tid = threadIdx.x; asm volatile("" : "+v"(tid));
    const int lane = tid & 63, r32 = lane & 31, hi = lane >> 5; (void)tid_; (void)lane_; (void)r32_; (void)hi_;
    LAS unsigned char* V_lds = lds + P2_V; LAS unsigned char* K_lds = lds + P2_K;
    LAS float* al_l = (LAS float*)(lds + P2_WS) + wid * 64 + 32;
    const LAS float* tab = (const LAS float*)(lds + P2_TAB);
    float m_reg = -1e30f, l_reg = 0.f;
#pragma unroll
    for (int d = 0; d < 4; ++d) o[d] = f32x16{};
    bf16x8 qr[4];
#pragma unroll
    for (int d0 = 0; d0 < 4; ++d0) qr[d0] = *(const bf16x8*)(Qw + (size_t)r32 * N_AC + d0 * 16 + hi * 8);
    const int krow = wid * 8 + (lane >> 3), kcolB = ((lane & 7) * 16) ^ (((krow >> 1) & 7) << 4);
    const unsigned koff = (unsigned)(krow * N_AC) * 2u + (unsigned)kcolB;
    unsigned voff[2];
#pragma unroll
    for (int i = 0; i < 2; ++i) { const int L = i * 8192 + wid * 1024 + lane * 16, st = L >> 9, win = L & 511, kk = (st >> 2) * 8 + (win >> 6), k = (kk & ~0xC) | ((kk & 4) << 1) | ((kk & 8) >> 1), c = (st & 3) * 32 + ((win & 63) >> 1);
        voff[i] = (unsigned)(k * N_AC + c) * 2u; }
    const int vb0 = (int)(uintptr_t)V_lds + v_rd_base(lane);
    int kro[4];
#pragma unroll
    for (int d0 = 0; d0 < 4; ++d0) kro[d0] = KSWZ64(r32, (d0 * 16 + hi * 8) * 2);
    constexpr int NT = SEQ / 64;
#define DMAK(t, slot) do { const int tt_ = (t) < NT ? (t) : NT - 1; __builtin_amdgcn_global_load_lds((const unsigned*)((const char*)Kh + (size_t)tt_ * 64 * N_AC * 2 + koff), (LAS unsigned*)(K_lds + (slot) * SHM_K + wid * 1024), 16, 0, 0); } while (0)
#define DMAV(t, slot) do { const int tt_ = (t) < NT ? (t) : NT - 1; const char* vt_ = (const char*)Vh + (size_t)tt_ * 64 * N_AC * 2; \
    __builtin_amdgcn_global_load_lds((const unsigned*)(vt_ + voff[0]), (LAS unsigned*)(V_lds + (slot) * SHM_V + wid * 1024), 16, 0, 0); \
    __builtin_amdgcn_global_load_lds((const unsigned*)(vt_ + voff[1]), (LAS unsigned*)(V_lds + (slot) * SHM_V + 8192 + wid * 1024), 16, 0, 0); } while (0)
#define WAITBAR(N) do { asm volatile("s_waitcnt vmcnt(" #N ") lgkmcnt(0)" ::: "memory"); __builtin_amdgcn_s_barrier(); asm volatile("" ::: "memory"); } while (0)
#define TBIDX(t) (((t) * 64 - qw0) >= 122 ? 384 : (((t) * 64 - qw0) <= -154 ? 0 : ((t) * 64 - qw0 + 224 - r32 + 4 * hi)))
#define TBASE(t) (((TBIDX(t)) & 3) * TABP + ((TBIDX(t)) & ~3))
#define KFRAG(i, kb) (*(const LAS bf16x8*)((kb) + kro[(i) >> 1] + ((i) & 1) * 4096))
#define BIASLD(P0, P1, t, g4) do { const LAS float* tb_ = tab + TBASE(t); const f32x4 a_ = *(const LAS f32x4*)(tb_ + 8 * (g4)), b_ = *(const LAS f32x4*)(tb_ + 32 + 8 * (g4)); \
    P0[4 * (g4)] = a_.x; P0[4 * (g4) + 1] = a_.y; P0[4 * (g4) + 2] = a_.z; P0[4 * (g4) + 3] = a_.w; P1[4 * (g4)] = b_.x; P1[4 * (g4) + 1] = b_.y; P1[4 * (g4) + 2] = b_.z; P1[4 * (g4) + 3] = b_.w; } while (0)
#define PKV(L, H) (bf16x8){L[0], L[1], L[2], L[3], H[0], H[1], H[2], H[3]}
#define PK4(P, BASE, OUT) do { unsigned a0 = cvt_pk_bf16(P[BASE + 0], P[BASE + 1]), a1 = cvt_pk_bf16(P[BASE + 2], P[BASE + 3]);   \
    unsigned b0 = cvt_pk_bf16(P[BASE + 4], P[BASE + 5]), b1 = cvt_pk_bf16(P[BASE + 6], P[BASE + 7]);                              \
    auto r0 = __builtin_amdgcn_permlane32_swap(a0, b0, false, false); auto r1 = __builtin_amdgcn_permlane32_swap(a1, b1, false, false); \
    v4u w_ = {r0[0], r1[0], r0[1], r1[1]}; OUT = __builtin_bit_cast(bf16x8, w_); } while (0)
#define VRD(LO, HI, i, vb, D0, KS) do { LO[i] = tr_read<v_rd_off(D0, KS, 0)>(vb); HI[i] = tr_read<v_rd_off(D0, KS, 1)>(vb); } while (0)
    f32x16 pA0, pA1, pB0, pB1; float alA = 1.f, alB = 1.f; bf16x8 pa0, pa1, pa2, pa3; bf16x8 kf[8];
    s16x4 rlo[8], rhi[8];
    int sk1 = 1, sk3 = 0, svm1 = 0, sv2 = 3;
    DMAK(0, 0); DMAV(0, 0); DMAK(1, 1); DMAV(1, 1); DMAK(2, 2); DMAV(2, 2); DMAK(3, 3);
    asm volatile("s_waitcnt vmcnt(0)" ::: "memory"); __builtin_amdgcn_s_barrier(); asm volatile("" ::: "memory");
#pragma unroll
    for (int g4 = 0; g4 < 4; ++g4) BIASLD(pA0, pA1, 0, g4);
#pragma unroll
    for (int i = 0; i < 8; ++i) kf[i] = KFRAG(i, K_lds);
#pragma unroll
    for (int i = 0; i < 8; ++i) { if (i & 1) pA1 = __builtin_amdgcn_mfma_f32_32x32x16_bf16(kf[i], qr[i >> 1], pA1, 0, 0, 0); else pA0 = __builtin_amdgcn_mfma_f32_32x32x16_bf16(kf[i], qr[i >> 1], pA0, 0, 0, 0); }
    { float pmax = pA0[0];
#pragma unroll
      for (int r = 1; r < 16; ++r) pmax = fmaxf(pmax, pA0[r]);
#pragma unroll
      for (int r = 0; r < 16; ++r) pmax = fmaxf(pmax, pA1[r]);
      { auto rr = __builtin_amdgcn_permlane32_swap(__float_as_uint(pmax), __float_as_uint(pmax), false, false); pmax = fmaxf(__uint_as_float(rr[0]), __uint_as_float(rr[1])); }
      pmax *= C2; m_reg = pmax; alA = 0.f; const float off = -pmax;
#pragma unroll
      for (int r = 0; r < 16; ++r) { pA0[r] = __builtin_amdgcn_exp2f(fmaf(pA0[r], C2, off)); pA1[r] = __builtin_amdgcn_exp2f(fmaf(pA1[r], C2, off)); } }
#pragma unroll
    for (int i = 0; i < 8; ++i) kf[i] = KFRAG(i, K_lds + SHM_K);
    asm volatile("s_waitcnt lgkmcnt(0)" ::: "memory"); __builtin_amdgcn_s_barrier(); asm volatile("" ::: "memory");
    if (wid >= 4) WAITBAR(3);
    int skp1 = 2; sk3 = 0; svm1 = 0; sv2 = 3; (void)sk1;
#define VF(f) PKV(rlo[(f) & 7], rhi[(f) & 7])
#define VISSUE(f) do { if ((f) < 16) VRD(rlo, rhi, (f) & 7, vbm_, (f) >> 2, (f) & 3); } while (0)
#define LW8() do { asm volatile("s_waitcnt lgkmcnt(8)" ::: "memory"); SBAR(); } while (0)
#define STEP(PN0, PN1, PO0, PO1, ALN, ALO, t) do { \
        DMAK((t) + 3, sk3); DMAV((t) + 2, sv2); \
        const int vbm_ = vb0 + svm1 * SHM_V; const LAS unsigned char* kb_ = K_lds + skp1 * SHM_K; const LAS unsigned char* kc_ = K_lds + (skp1 == 0 ? NKS - 1 : skp1 - 1) * SHM_K; \
        float sacc_ = 0.f; \
          \
        SBAR(); \
        kf[4] = KFRAG(4, kc_); kf[5] = KFRAG(5, kc_); kf[6] = KFRAG(6, kc_); kf[7] = KFRAG(7, kc_); SBAR(); \
        PN0 = __builtin_amdgcn_mfma_f32_32x32x16_bf16(kf[0], qr[0], f32x16{}, 0, 0, 0); sacc_ += (PO0[0] + PO0[1]) + (PO0[2] + PO0[3]); SBAR(); \
        PN1 = __builtin_amdgcn_mfma_f32_32x32x16_bf16(kf[1], qr[0], f32x16{}, 0, 0, 0); sacc_ += (PO0[4] + PO0[5]) + (PO0[6] + PO0[7]); PK4(PO0, 0, pa0); SBAR(); \
        PN0 = __builtin_amdgcn_mfma_f32_32x32x16_bf16(kf[2], qr[1], PN0, 0, 0, 0); sacc_ += (PO0[8] + PO0[9]) + (PO0[10] + PO0[11]); SBAR(); \
        PN1 = __builtin_amdgcn_mfma_f32_32x32x16_bf16(kf[3], qr[1], PN1, 0, 0, 0); sacc_ += (PO0[12] + PO0[13]) + (PO0[14] + PO0[15]); PK4(PO0, 8, pa1); SBAR(); \
        PN0 = __builtin_amdgcn_mfma_f32_32x32x16_bf16(kf[4], qr[2], PN0, 0, 0, 0); VISSUE(0); sacc_ += (PO1[0] + PO1[1]) + (PO1[2] + PO1[3]); SBAR(); \
        PN1 = __builtin_amdgcn_mfma_f32_32x32x16_bf16(kf[5], qr[2], PN1, 0, 0, 0); VISSUE(1); sacc_ += (PO1[4] + PO1[5]) + (PO1[6] + PO1[7]); PK4(PO1, 0, pa2); SBAR(); \
        PN0 = __builtin_amdgcn_mfma_f32_32x32x16_bf16(kf[6], qr[3], PN0, 0, 0, 0); VISSUE(2); sacc_ += (PO1[8] + PO1[9]) + (PO1[10] + PO1[11]); SBAR(); \
        PN1 = __builtin_amdgcn_mfma_f32_32x32x16_bf16(kf[7], qr[3], PN1, 0, 0, 0); VISSUE(3); sacc_ += (PO1[12] + PO1[13]) + (PO1[14] + PO1[15]); PK4(PO1, 8, pa3); SBAR(); \
        { auto rr_ = __builtin_amdgcn_permlane32_swap(__float_as_uint(sacc_), __float_as_uint(sacc_), false, false); sacc_ = __uint_as_float(rr_[0]) + __uint_as_float(rr_[1]); } \
        l_reg = l_reg * ALO + sacc_; \
        WAITBAR(3); SBAR(); \
          \
        const int dl_ = (t) * 64 - qw0; const float cst_ = dl_ >= 122 ? cR : (dl_ <= -154 ? cL : 0.f); \
        if (dl_ < 122 && dl_ > -154) { const LAS float* tb_ = tab + TBASE(t); _Pragma("unroll") for (int g4 = 0; g4 < 4; ++g4) { const f32x4 a_ = *(const LAS f32x4*)(tb_ + 8 * g4), b_ = *(const LAS f32x4*)(tb_ + 32 + 8 * g4); \
            PN0[4 * g4] += a_.x; PN0[4 * g4 + 1] += a_.y; PN0[4 * g4 + 2] += a_.z; PN0[4 * g4 + 3] += a_.w; PN1[4 * g4] += b_.x; PN1[4 * g4 + 1] += b_.y; PN1[4 * g4 + 2] += b_.z; PN1[4 * g4 + 3] += b_.w; } } \
        VISSUE(4); o[0] = __builtin_amdgcn_mfma_f32_32x32x16_bf16(pa0, VF(0), o[0], 0, 0, 0); \
        float pm0_ = fmaxf(fmaxf(PN0[0], PN0[1]), PN0[2]), pm1_ = fmaxf(fmaxf(PN0[3], PN0[4]), PN0[5]); pm0_ = fmaxf(fmaxf(pm0_, PN0[6]), PN0[7]); pm1_ = fmaxf(fmaxf(pm1_, PN0[8]), PN0[9]); SBAR(); \
        VISSUE(5); o[0] = __builtin_amdgcn_mfma_f32_32x32x16_bf16(pa1, VF(1), o[0], 0, 0, 0); \
        pm0_ = fmaxf(fmaxf(pm0_, PN0[10]), PN0[11]); pm1_ = fmaxf(fmaxf(pm1_, PN0[12]), PN0[13]); pm0_ = fmaxf(fmaxf(pm0_, PN0[14]), PN0[15]); pm1_ = fmaxf(fmaxf(pm1_, PN1[0]), PN1[1]); SBAR(); \
        VISSUE(6); o[0] = __builtin_amdgcn_mfma_f32_32x32x16_bf16(pa2, VF(2), o[0], 0, 0, 0); \
        pm0_ = fmaxf(fmaxf(pm0_, PN1[2]), PN1[3]); pm1_ = fmaxf(fmaxf(pm1_, PN1[4]), PN1[5]); pm0_ = fmaxf(fmaxf(pm0_, PN1[6]), PN1[7]); pm1_ = fmaxf(fmaxf(pm1_, PN1[8]), PN1[9]); SBAR(); \
        VISSUE(7); o[0] = __builtin_amdgcn_mfma_f32_32x32x16_bf16(pa3, VF(3), o[0], 0, 0, 0); \
        pm0_ = fmaxf(fmaxf(pm0_, PN1[10]), PN1[11]); pm1_ = fmaxf(fmaxf(pm1_, PN1[12]), PN1[13]); pm0_ = fmaxf(fmaxf(pm0_, PN1[14]), PN1[15]); float pmax_ = fmaxf(pm0_, pm1_); \
        { auto rr_ = __builtin_amdgcn_permlane32_swap(__float_as_uint(pmax_), __float_as_uint(pmax_), false, false); pmax_ = fmaxf(__uint_as_float(rr_[0]), __uint_as_float(rr_[1])); } \
        pmax_ = fmaf(pmax_, C2, cst_); float mn_; \
        if (__builtin_expect(__all(pmax_ - m_reg <= THR2), 1)) { mn_ = m_reg; ALN = 1.f; } else { mn_ = fmaxf(m_reg, pmax_); ALN = __builtin_amdgcn_exp2f(m_reg - mn_); m_reg = mn_; } \
        const float off_ = cst_ - mn_; SBAR(); \
        VISSUE(8);  LW8(); o[1] = __builtin_amdgcn_mfma_f32_32x32x16_bf16(pa0, VF(4), o[1], 0, 0, 0); EX4(PN0, 0); SBAR(); \
        VISSUE(9);  LW8(); o[1] = __builtin_amdgcn_mfma_f32_32x32x16_bf16(pa1, VF(5), o[1], 0, 0, 0); EX4(PN0, 4); SBAR(); \
        VISSUE(10); LW8(); o[1] = __builtin_amdgcn_mfma_f32_32x32x16_bf16(pa2, VF(6), o[1], 0, 0, 0); EX4(PN0, 8); SBAR(); \
        VISSUE(11); LW8(); o[1] = __builtin_amdgcn_mfma_f32_32x32x16_bf16(pa3, VF(7), o[1], 0, 0, 0); EX4(PN0, 12); SBAR(); \
        VISSUE(12); LW8(); o[2] = __builtin_amdgcn_mfma_f32_32x32x16_bf16(pa0, VF(8), o[2], 0, 0, 0);  kf[0] = KFRAG(0, kb_); EX4(PN1, 0); SBAR(); \
        VISSUE(13); LW8(); o[2] = __builtin_amdgcn_mfma_f32_32x32x16_bf16(pa1, VF(9), o[2], 0, 0, 0);  kf[1] = KFRAG(1, kb_); EX2(PN1, 4); SBAR(); \
        VISSUE(14); LW8(); o[2] = __builtin_amdgcn_mfma_f32_32x32x16_bf16(pa2, VF(10), o[2], 0, 0, 0); kf[2] = KFRAG(2, kb_); EX2(PN1, 6); SBAR(); \
        VISSUE(15); LW8(); o[2] = __builtin_amdgcn_mfma_f32_32x32x16_bf16(pa3, VF(11), o[2], 0, 0, 0); kf[3] = KFRAG(3, kb_); EX2(PN1, 8); SBAR(); \
        LW8(); o[3] = __builtin_amdgcn_mfma_f32_32x32x16_bf16(pa0, VF(12), o[3], 0, 0, 0); EX2(PN1, 10); SBAR(); \
        LW8(); o[3] = __builtin_amdgcn_mfma_f32_32x32x16_bf16(pa1, VF(13), o[3], 0, 0, 0); EX2(PN1, 12); SBAR(); \
        LW8(); o[3] = __builtin_amdgcn_mfma_f32_32x32x16_bf16(pa2, VF(14), o[3], 0, 0, 0); EX2(PN1, 14); SBAR(); \
        asm volatile("s_waitcnt lgkmcnt(3)" ::: "memory"); SBAR(); o[3] = __builtin_amdgcn_mfma_f32_32x32x16_bf16(pa3, VF(15), o[3], 0, 0, 0); SBAR(); \
        if (__any(ALN < 1.f)) { if (hi == 0) al_l[r32] = ALN; asm volatile("s_waitcnt lgkmcnt(0)" ::: "memory"); \
            _Pragma("unroll") for (int d = 0; d < 4; ++d) _Pragma("unroll") for (int r = 0; r < 16; ++r) o[d][r] *= al_l[crow(r, hi)]; } \
        WAITBAR(3); \
        skp1 = (skp1 == NKS - 1) ? 0 : skp1 + 1; sk3 = (sk3 == NKS - 1) ? 0 : sk3 + 1; svm1 = (svm1 == NVS - 1) ? 0 : svm1 + 1; sv2 = (sv2 == NVS - 1) ? 0 : sv2 + 1; } while (0)
#define EX4(P, B) do { P[B] = __builtin_amdgcn_exp2f(fmaf(P[B], C2, off_)); P[B + 1] = __builtin_amdgcn_exp2f(fmaf(P[B + 1], C2, off_)); P[B + 2] = __builtin_amdgcn_exp2f(fmaf(P[B + 2], C2, off_)); P[B + 3] = __builtin_amdgcn_exp2f(fmaf(P[B + 3], C2, off_)); } while (0)
#define EX2(P, B) do { P[B] = __builtin_amdgcn_exp2f(fmaf(P[B], C2, off_)); P[B + 1] = __builtin_amdgcn_exp2f(fmaf(P[B + 1], C2, off_)); } while (0)
#pragma unroll 1
    for (int j = 1; j + 1 < NT; j += 2) {
        STEP(pB0, pB1, pA0, pA1, alB, alA, j);
        STEP(pA0, pA1, pB0, pB1, alA, alB, j + 1);
    }
    STEP(pB0, pB1, pA0, pA1, alB, alA, NT - 1);
    if (wid < 4) WAITBAR(3);
    { float sacc = 0.f;
#pragma unroll
      for (int r = 0; r < 16; ++r) sacc += pB0[r] + pB1[r];
      { auto rr = __builtin_amdgcn_permlane32_swap(__float_as_uint(sacc), __float_as_uint(sacc), false, false); sacc = __uint_as_float(rr[0]) + __uint_as_float(rr[1]); }
      l_reg = l_reg * alB + sacc;
      PK4(pB0, 0, pa0); PK4(pB0, 8, pa1); PK4(pB1, 0, pa2); PK4(pB1, 8, pa3); SBAR();
      pv_d0(o, vb0 + svm1 * SHM_V, pa0, pa1, pa2, pa3); }
#undef STEP
#undef EX4
#undef EX2
#undef VF
#undef VISSUE
#undef LW8
    l_out = l_reg;
    asm volatile("s_waitcnt vmcnt(0)" ::: "memory");
    __syncthreads();
#undef DMAK
#undef DMAV
#undef WAITBAR
#undef TBIDX
#undef TBASE
#undef KFRAG
#undef BIASLD
#undef PKV
#undef PK4
#undef VRD
}
__device__ __forceinline__ void pass3(const bf16* __restrict__ Qw, const bf16* __restrict__ Kh, const bf16* __restrict__ Vh, LAS unsigned char* lds, f32x16 (&o)[4], float& l_out,
                                      int tid_, int wid, int lane_, int r32_, int hi_, int qw0) {
    int tid = threadIdx.x; asm volatile("" : "+v"(tid));
    const int lane = tid & 63, r32 = lane & 31, hi = lane >> 5; (void)tid_; (void)lane_; (void)r32_; (void)hi_;
    LAS unsigned char* V_lds = lds + P2_V; LAS unsigned char* K_lds = lds + P2_K;
    const LAS float* tab = (const LAS float*)(lds + P2_TAB);
    float l_reg = 0.f;
#pragma unroll
    for (int d = 0; d < 4; ++d) o[d] = f32x16{};
    bf16x8 qr[4];
#pragma unroll
    for (int d0 = 0; d0 < 4; ++d0) qr[d0] = *(const bf16x8*)(Qw + (size_t)r32 * N_AC + d0 * 16 + hi * 8);
    const int krow = wid * 8 + (lane >> 3), kcolB = ((lane & 7) * 16) ^ (((krow >> 1) & 7) << 4);
    const unsigned koff = (unsigned)(krow * N_AC) * 2u + (unsigned)kcolB;
    unsigned voff[2];
#pragma unroll
    for (int i = 0; i < 2; ++i) { const int L = i * 8192 + wid * 1024 + lane * 16, st = L >> 9, win = L & 511, kk = (st >> 2) * 8 + (win >> 6), k = (kk & ~0xC) | ((kk & 4) << 1) | ((kk & 8) >> 1), c = (st & 3) * 32 + ((win & 63) >> 1);
        voff[i] = (unsigned)(k * N_AC + c) * 2u; }
    const int vb0 = (int)(uintptr_t)V_lds + v_rd_base(lane);
    int kro[4];
#pragma unroll
    for (int d0 = 0; d0 < 4; ++d0) kro[d0] = KSWZ64(r32, (d0 * 16 + hi * 8) * 2);
    constexpr int NT = SEQ / 64;
#define DMAK(t, slot) do { const int tt_ = (t) < NT ? (t) : NT - 1; __builtin_amdgcn_global_load_lds((const unsigned*)((const char*)Kh + (size_t)tt_ * 64 * N_AC * 2 + koff), (LAS unsigned*)(K_lds + (slot) * SHM_K + wid * 1024), 16, 0, 0); } while (0)
#define DMAV(t, slot) do { const int tt_ = (t) < NT ? (t) : NT - 1; const char* vt_ = (const char*)Vh + (size_t)tt_ * 64 * N_AC * 2; \
    __builtin_amdgcn_global_load_lds((const unsigned*)(vt_ + voff[0]), (LAS unsigned*)(V_lds + (slot) * SHM_V + wid * 1024), 16, 0, 0); \
    __builtin_amdgcn_global_load_lds((const unsigned*)(vt_ + voff[1]), (LAS unsigned*)(V_lds + (slot) * SHM_V + 8192 + wid * 1024), 16, 0, 0); } while (0)
#define WAITBAR(N) do { asm volatile("s_waitcnt vmcnt(" #N ") lgkmcnt(0)" ::: "memory"); __builtin_amdgcn_s_barrier(); asm volatile("" ::: "memory"); } while (0)
#define TBIDX(t) (((t) * 64 - qw0) >= 122 ? 384 : (((t) * 64 - qw0) <= -154 ? 0 : ((t) * 64 - qw0 + 224 - r32 + 4 * hi)))
#define TBASE(t) (((TBIDX(t)) & 3) * TABP + ((TBIDX(t)) & ~3))
#define KFRAG(i, kb) (*(const LAS bf16x8*)((kb) + kro[(i) >> 1] + ((i) & 1) * 4096))
#define BIASLD(P0, P1, t, g4) do { const LAS float* tb_ = tab + TBASE(t); const f32x4 a_ = *(const LAS f32x4*)(tb_ + 8 * (g4)), b_ = *(const LAS f32x4*)(tb_ + 32 + 8 * (g4)); \
    P0[4 * (g4)] = a_.x; P0[4 * (g4) + 1] = a_.y; P0[4 * (g4) + 2] = a_.z; P0[4 * (g4) + 3] = a_.w; P1[4 * (g4)] = b_.x; P1[4 * (g4) + 1] = b_.y; P1[4 * (g4) + 2] = b_.z; P1[4 * (g4) + 3] = b_.w; } while (0)
#define PKV(L, H) (bf16x8){L[0], L[1], L[2], L[3], H[0], H[1], H[2], H[3]}
#define PK4(P, BASE, OUT) do { unsigned a0 = cvt_pk_bf16(P[BASE + 0], P[BASE + 1]), a1 = cvt_pk_bf16(P[BASE + 2], P[BASE + 3]);   \
    unsigned b0 = cvt_pk_bf16(P[BASE + 4], P[BASE + 5]), b1 = cvt_pk_bf16(P[BASE + 6], P[BASE + 7]);                              \
    auto r0 = __builtin_amdgcn_permlane32_swap(a0, b0, false, false); auto r1 = __builtin_amdgcn_permlane32_swap(a1, b1, false, false); \
    v4u w_ = {r0[0], r1[0], r0[1], r1[1]}; OUT = __builtin_bit_cast(bf16x8, w_); } while (0)
#define VRD(LO, HI, i, vb, D0, KS) do { LO[i] = tr_read<v_rd_off(D0, KS, 0)>(vb); HI[i] = tr_read<v_rd_off(D0, KS, 1)>(vb); } while (0)
    f32x16 pA0, pA1, pB0, pB1; bf16x8 pa0, pa1, pa2, pa3; bf16x8 kf[8];
    s16x4 rlo[8], rhi[8];
    int sk1 = 1, sk3 = 0, svm1 = 0, sv2 = 3;
    DMAK(0, 0); DMAV(0, 0); DMAK(1, 1); DMAV(1, 1); DMAK(2, 2); DMAV(2, 2); DMAK(3, 3);
    asm volatile("s_waitcnt vmcnt(0)" ::: "memory"); __builtin_amdgcn_s_barrier(); asm volatile("" ::: "memory");
    if (qw0 < 154) {
#pragma unroll
      for (int g4 = 0; g4 < 4; ++g4) BIASLD(pA0, pA1, 0, g4); }
    else { pA0 = f32x16{}; pA1 = f32x16{}; }
#pragma unroll
    for (int i = 0; i < 8; ++i) kf[i] = KFRAG(i, K_lds);
#pragma unroll
    for (int i = 0; i < 8; ++i) { if (i & 1) pA1 = __builtin_amdgcn_mfma_f32_32x32x16_bf16(kf[i], qr[i >> 1], pA1, 0, 0, 0); else pA0 = __builtin_amdgcn_mfma_f32_32x32x16_bf16(kf[i], qr[i >> 1], pA0, 0, 0, 0); }
#pragma unroll
    for (int r = 0; r < 16; ++r) { pA0[r] = __builtin_amdgcn_exp2f(pA0[r]); pA1[r] = __builtin_amdgcn_exp2f(pA1[r]); }
#pragma unroll
    for (int i = 0; i < 8; ++i) kf[i] = KFRAG(i, K_lds + SHM_K);
    asm volatile("s_waitcnt lgkmcnt(0)" ::: "memory"); __builtin_amdgcn_s_barrier(); asm volatile("" ::: "memory");
    if (wid >= 4) WAITBAR(3);
    int skp1 = 2; sk3 = 0; svm1 = 0; sv2 = 3; (void)sk1;
#define VF(f) PKV(rlo[(f) & 7], rhi[(f) & 7])
#define VISSUE(f) do { if ((f) < 16) VRD(rlo, rhi, (f) & 7, vbm_, (f) >> 2, (f) & 3); } while (0)
#define LW8() do { asm volatile("s_waitcnt lgkmcnt(8)" ::: "memory"); SBAR(); } while (0)
#define LW12() do { asm volatile("s_waitcnt lgkmcnt(12)" ::: "memory"); SBAR(); } while (0)
#define STEP(PN0, PN1, PO0, PO1, t) do { \
        DMAK((t) + 3, sk3); DMAV((t) + 2, sv2); \
        const int vbm_ = vb0 + svm1 * SHM_V; const LAS unsigned char* kb_ = K_lds + skp1 * SHM_K; const LAS unsigned char* kc_ = K_lds + (skp1 == 0 ? NKS - 1 : skp1 - 1) * SHM_K; \
        float sacc_ = 0.f; \
          \
        SBAR(); \
          \
        PN0 = __builtin_amdgcn_mfma_f32_32x32x16_bf16(kf[0], qr[0], f32x16{}, 0, 0, 0); kf[4] = KFRAG(4, kc_); kf[5] = KFRAG(5, kc_); sacc_ += (PO0[0] + PO0[1]) + (PO0[2] + PO0[3]); SBAR(); \
        PN1 = __builtin_amdgcn_mfma_f32_32x32x16_bf16(kf[1], qr[0], f32x16{}, 0, 0, 0); kf[6] = KFRAG(6, kc_); kf[7] = KFRAG(7, kc_); sacc_ += (PO0[4] + PO0[5]) + (PO0[6] + PO0[7]); PK4(PO0, 0, pa0); SBAR(); \
        PN0 = __builtin_amdgcn_mfma_f32_32x32x16_bf16(kf[2], qr[1], PN0, 0, 0, 0); VISSUE(0); sacc_ += (PO0[8] + PO0[9]) + (PO0[10] + PO0[11]); SBAR(); \
        PN1 = __builtin_amdgcn_mfma_f32_32x32x16_bf16(kf[3], qr[1], PN1, 0, 0, 0); VISSUE(1); sacc_ += (PO0[12] + PO0[13]) + (PO0[14] + PO0[15]); PK4(PO0, 8, pa1); SBAR(); \
        PN0 = __builtin_amdgcn_mfma_f32_32x32x16_bf16(kf[4], qr[2], PN0, 0, 0, 0); VISSUE(2); sacc_ += (PO1[0] + PO1[1]) + (PO1[2] + PO1[3]); SBAR(); \
        PN1 = __builtin_amdgcn_mfma_f32_32x32x16_bf16(kf[5], qr[2], PN1, 0, 0, 0); VISSUE(3); sacc_ += (PO1[4] + PO1[5]) + (PO1[6] + PO1[7]); PK4(PO1, 0, pa2); SBAR(); \
        PN0 = __builtin_amdgcn_mfma_f32_32x32x16_bf16(kf[6], qr[3], PN0, 0, 0, 0); VISSUE(4); sacc_ += (PO1[8] + PO1[9]) + (PO1[10] + PO1[11]); SBAR(); \
        PN1 = __builtin_amdgcn_mfma_f32_32x32x16_bf16(kf[7], qr[3], PN1, 0, 0, 0); VISSUE(5); sacc_ += (PO1[12] + PO1[13]) + (PO1[14] + PO1[15]); PK4(PO1, 8, pa3); SBAR(); \
        { auto rr_ = __builtin_amdgcn_permlane32_swap(__float_as_uint(sacc_), __float_as_uint(sacc_), false, false); sacc_ = __uint_as_float(rr_[0]) + __uint_as_float(rr_[1]); } \
        l_reg += sacc_; \
        WAITBAR(3); SBAR(); \
          \
        const int dl_ = (t) * 64 - qw0; \
        if (dl_ < 122 && dl_ > -154) { const LAS float* tb_ = tab + TBASE(t); _Pragma("unroll") for (int g4 = 0; g4 < 4; ++g4) { const f32x4 a_ = *(const LAS f32x4*)(tb_ + 8 * g4), b_ = *(const LAS f32x4*)(tb_ + 32 + 8 * g4); \
            PN0[4 * g4] += a_.x; PN0[4 * g4 + 1] += a_.y; PN0[4 * g4 + 2] += a_.z; PN0[4 * g4 + 3] += a_.w; PN1[4 * g4] += b_.x; PN1[4 * g4 + 1] += b_.y; PN1[4 * g4 + 2] += b_.z; PN1[4 * g4 + 3] += b_.w; } } \
        VISSUE(6);  LW12(); o[0] = __builtin_amdgcn_mfma_f32_32x32x16_bf16(pa0, VF(0), o[0], 0, 0, 0); SBAR(); \
        VISSUE(7);  LW12(); o[0] = __builtin_amdgcn_mfma_f32_32x32x16_bf16(pa1, VF(1), o[0], 0, 0, 0); EX2(PN0, 0); SBAR(); \
        VISSUE(8);  LW12(); o[0] = __builtin_amdgcn_mfma_f32_32x32x16_bf16(pa2, VF(2), o[0], 0, 0, 0); EX2(PN0, 2); SBAR(); \
        VISSUE(9);  LW12(); o[0] = __builtin_amdgcn_mfma_f32_32x32x16_bf16(pa3, VF(3), o[0], 0, 0, 0); EX2(PN0, 4); SBAR(); \
        VISSUE(10); LW12(); o[1] = __builtin_amdgcn_mfma_f32_32x32x16_bf16(pa0, VF(4), o[1], 0, 0, 0); EX2(PN0, 6); SBAR(); \
        VISSUE(11); LW12(); o[1] = __builtin_amdgcn_mfma_f32_32x32x16_bf16(pa1, VF(5), o[1], 0, 0, 0); EX2(PN0, 8); SBAR(); \
        VISSUE(12); LW12(); o[1] = __builtin_amdgcn_mfma_f32_32x32x16_bf16(pa2, VF(6), o[1], 0, 0, 0); EX2(PN0, 10); SBAR(); \
        VISSUE(13); LW12(); o[1] = __builtin_amdgcn_mfma_f32_32x32x16_bf16(pa3, VF(7), o[1], 0, 0, 0); EX4(PN0, 12); SBAR(); \
        VISSUE(14); LW12(); o[2] = __builtin_amdgcn_mfma_f32_32x32x16_bf16(pa0, VF(8), o[2], 0, 0, 0);  EX2(PN1, 0); SBAR(); \
        VISSUE(15); LW12(); o[2] = __builtin_amdgcn_mfma_f32_32x32x16_bf16(pa1, VF(9), o[2], 0, 0, 0);  EX2(PN1, 2); SBAR(); \
        kf[0] = KFRAG(0, kb_); asm volatile("s_waitcnt lgkmcnt(11)" ::: "memory"); SBAR(); o[2] = __builtin_amdgcn_mfma_f32_32x32x16_bf16(pa2, VF(10), o[2], 0, 0, 0); EX2(PN1, 4); SBAR(); \
        kf[1] = KFRAG(1, kb_); asm volatile("s_waitcnt lgkmcnt(10)" ::: "memory"); SBAR(); o[2] = __builtin_amdgcn_mfma_f32_32x32x16_bf16(pa3, VF(11), o[2], 0, 0, 0); EX2(PN1, 6); SBAR(); \
        kf[2] = KFRAG(2, kb_); asm volatile("s_waitcnt lgkmcnt(9)" ::: "memory"); SBAR(); o[3] = __builtin_amdgcn_mfma_f32_32x32x16_bf16(pa0, VF(12), o[3], 0, 0, 0); EX2(PN1, 8); SBAR(); \
        kf[3] = KFRAG(3, kb_); asm volatile("s_waitcnt lgkmcnt(8)" ::: "memory"); SBAR(); o[3] = __builtin_amdgcn_mfma_f32_32x32x16_bf16(pa1, VF(13), o[3], 0, 0, 0); EX2(PN1, 10); SBAR(); \
        asm volatile("s_waitcnt lgkmcnt(6)" ::: "memory"); SBAR(); o[3] = __builtin_amdgcn_mfma_f32_32x32x16_bf16(pa2, VF(14), o[3], 0, 0, 0); EX4(PN1, 12); SBAR(); \
        asm volatile("s_waitcnt lgkmcnt(4)" ::: "memory"); SBAR(); o[3] = __builtin_amdgcn_mfma_f32_32x32x16_bf16(pa3, VF(15), o[3], 0, 0, 0); SBAR(); \
        if (dl_ > -154 && dl_ <= -90) { const float fL = ((const LAS float*)(lds + P2_END))[0]; l_reg *= fL; _Pragma("unroll") for (int d = 0; d < 4; ++d) _Pragma("unroll") for (int r = 0; r < 16; ++r) o[d][r] *= fL; }             \
        else if (dl_ >= 122 && dl_ < 186) { const float fRi = ((const LAS float*)(lds + P2_END))[1]; l_reg *= fRi; _Pragma("unroll") for (int d = 0; d < 4; ++d) _Pragma("unroll") for (int r = 0; r < 16; ++r) o[d][r] *= fRi; }       \
        WAITBAR(3); \
        skp1 = (skp1 == NKS - 1) ? 0 : skp1 + 1; sk3 = (sk3 == NKS - 1) ? 0 : sk3 + 1; svm1 = (svm1 == NVS - 1) ? 0 : svm1 + 1; sv2 = (sv2 == NVS - 1) ? 0 : sv2 + 1; } while (0)
#define EX4(P, B) do { P[B] = __builtin_amdgcn_exp2f(P[B]); P[B + 1] = __builtin_amdgcn_exp2f(P[B + 1]); P[B + 2] = __builtin_amdgcn_exp2f(P[B + 2]); P[B + 3] = __builtin_amdgcn_exp2f(P[B + 3]); } while (0)
#define EX2(P, B) do { P[B] = __builtin_amdgcn_exp2f(P[B]); P[B + 1] = __builtin_amdgcn_exp2f(P[B + 1]); } while (0)
#pragma unroll 1
    for (int j = 1; j + 1 < NT; j += 2) {
        STEP(pB0, pB1, pA0, pA1, j);
        STEP(pA0, pA1, pB0, pB1, j + 1);
    }
    STEP(pB0, pB1, pA0, pA1, NT - 1);
    if (wid < 4) WAITBAR(3);
    { float sacc = 0.f;
#pragma unroll
      for (int r = 0; r < 16; ++r) sacc += pB0[r] + pB1[r];
      { auto rr = __builtin_amdgcn_permlane32_swap(__float_as_uint(sacc), __float_as_uint(sacc), false, false); sacc = __uint_as_float(rr[0]) + __uint_as_float(rr[1]); }
      l_reg += sacc;
      PK4(pB0, 0, pa0); PK4(pB0, 8, pa1); PK4(pB1, 0, pa2); PK4(pB1, 8, pa3); SBAR();
      pv_d0(o, vb0 + svm1 * SHM_V, pa0, pa1, pa2, pa3); }
#undef STEP
#undef EX4
#undef EX2
#undef VF
#undef VISSUE
#undef LW8
#undef LW12
    l_out = l_reg;
    asm volatile("s_waitcnt vmcnt(0)" ::: "memory");
    __syncthreads();
#undef DMAK
#undef DMAV
#undef WAITBAR
#undef TBIDX
#undef TBASE
#undef KFRAG
#undef BIASLD
#undef PKV
#undef PK4
#undef VRD
}
#undef SBAR
}
__device__ __forceinline__ bool wg_any(Frame& F, bool pred) {
    if (pred) F.MISC[12] = 1u;
    __syncthreads();
    const unsigned f = F.MISC[12];
    __syncthreads();
    if (f && F.tid == 0) F.MISC[12] = 0u;
    return f != 0u;
}
template <int VAR> __device__ __forceinline__ void phase_attnA(Frame& F, const Args& a, int layer) {
    const bf16* PAC = (const bf16*)(a.ws + WS_P); float* OS = (float*)(a.ws + WS_OA); const float* bta = (const float*)(a.ws + WS_BTA); bf16* Y = (bf16*)(a.ws + WS_Y);
    const float* lp = a.in[4] + layer * 256; const float* sg = a.in[5] + layer * 128;
    const float lam_init = 0.8f - 0.6f * expf(-0.3f * (float)layer);
    const float s01 = wave_sum(lp[F.lane] * lp[64 + F.lane]), s23 = wave_sum(lp[128 + F.lane] * lp[192 + F.lane]);
    const float lam = expf(s01) - expf(s23) + lam_init;
    const int tid = F.tid, lane = F.lane, wid = F.wave, r32 = lane & 31, hi = lane >> 5;
    LAS float* tab = (LAS float*)(F.lds + da::P2_TAB); LAS float* li_l = (LAS float*)(F.lds + da::P2_WS) + wid * 64;
    const char* osb = (const char*)(OS + (size_t)blockIdx.x * (64 * 512));
    for (int unit = F.vcu; unit < BATCH * 4 * 16; unit += F.G) {
        const int qb = unit & 15, h = (unit >> 4) & 3, b = unit >> 6;
        __syncthreads();
        for (int i = tid; i < 4 * da::TABP; i += 512) { const int c = i / da::TABP, j = i % da::TABP; int rel = j + c - 224; rel = rel < -160 ? -160 : (rel > 159 ? 159 : rel); tab[i] = bta[h * 8192 + 4095 + rel] * LOG2E; }
        if (tid == 0) { const float cL = bta[h * 8192] * LOG2E, cR = bta[h * 8192 + 8190] * LOG2E; LAS float* fc = (LAS float*)(F.lds + da::P2_END);
            fc[0] = __builtin_amdgcn_exp2f(cL); fc[1] = __builtin_amdgcn_exp2f(-cR); fc[2] = cL; fc[3] = cR; }
        __syncthreads();
        const size_t rowb = (size_t)b * SEQ; const int qw0 = qb * 256 + wid * 32;
        f32x16 o[4]; float l;
        da::pass3(PAC + (rowb + qw0) * N_AC + h * 128, PAC + rowb * N_AC + 512 + h * 128, PAC + rowb * N_AC + 1024 + h * 128, F.lds, o, l, tid, wid, lane, r32, hi, qw0);
        if (wg_any(F, !(l > 0x1p-100f && l < 0x1p100f)))
            da::pass2(PAC + (rowb + qw0) * N_AC + h * 128, PAC + rowb * N_AC + 512 + h * 128, PAC + rowb * N_AC + 1024 + h * 128, F.lds, o, l, tid, wid, lane, r32, hi, qw0, ((const LAS float*)(F.lds + da::P2_END))[2], ((const LAS float*)(F.lds + da::P2_END))[3]);
        if (hi == 0) li_l[r32] = l;
        LDS_WAIT();
        { int t_ = threadIdx.x; asm volatile("" : "+v"(t_)); char* pp = (char*)osb + (unsigned)t_ * 4u;
#pragma unroll
          for (int r = 0; r < 16; ++r) { const float il = __builtin_amdgcn_rcpf(li_l[crow(r, hi)]);
#pragma unroll
            for (int d0 = 0; d0 < 4; ++d0) { *(float*)pp = o[d0][r] * il; pp += 2048; asm volatile("" : "+v"(pp)); } } }
        LDS_WAIT();
        da::pass3(PAC + (rowb + qw0) * N_AC + h * 128 + 64, PAC + rowb * N_AC + 512 + h * 128 + 64, PAC + rowb * N_AC + 1024 + h * 128, F.lds, o, l, tid, wid, lane, r32, hi, qw0);
        if (wg_any(F, !(l > 0x1p-100f && l < 0x1p100f)))
            da::pass2(PAC + (rowb + qw0) * N_AC + h * 128 + 64, PAC + rowb * N_AC + 512 + h * 128 + 64, PAC + rowb * N_AC + 1024 + h * 128, F.lds, o, l, tid, wid, lane, r32, hi, qw0, ((const LAS float*)(F.lds + da::P2_END))[2], ((const LAS float*)(F.lds + da::P2_END))[3]);
        if (hi == 0) li_l[r32] = l;
        LDS_WAIT();
        float sgv[4];
#pragma unroll
        for (int d0 = 0; d0 < 4; ++d0) sgv[d0] = sg[d0 * 32 + r32] * (1.f - lam_init);
        { int t_ = threadIdx.x; asm volatile("" : "+v"(t_)); const char* pp = osb + (unsigned)t_ * 4u; char* yp = (char*)(Y + (rowb + qw0) * 1536 + h * 128) + (unsigned)(4 * ((t_ >> 5) & 1) * 1536 + (t_ & 31)) * 2u;
#pragma unroll
          for (int r = 0; r < 16; ++r) { const float il = __builtin_amdgcn_rcpf(li_l[crow(r, hi)]); float y[4]; float ss = 0.f;
#pragma unroll
            for (int d0 = 0; d0 < 4; ++d0) { y[d0] = *(const float*)pp - lam * (o[d0][r] * il); ss += y[d0] * y[d0]; pp += 2048; asm volatile("" : "+v"(pp)); }
            ss = half_sum(ss, hi);
            const float rs = 1.f / sqrtf(ss * (1.f / 128.f) + EPS);
            if (!a.dry) {
#pragma unroll
              for (int d0 = 0; d0 < 4; ++d0) *(bf16*)(yp + d0 * 64) = (bf16)f2bf(y[d0] * rs * sgv[d0]); } else asm volatile("" :: "v"(y[0]), "v"(y[1]), "v"(y[2]), "v"(y[3]), "v"(rs));
            yp += ((r & 3) == 3 ? 5 : 1) * 3072; asm volatile("" : "+v"(yp)); } }
        LDS_WAIT();
    }
    __syncthreads();
}
__device__ __forceinline__ float gelu_tanh(float x) { const float x2 = x * x; const float t = x * fmaf(x2, -2.f * 0.7978845608028654f * 0.044715f * LOG2E, -2.f * 0.7978845608028654f * LOG2E);
    return x * __builtin_amdgcn_rcpf(1.f + __builtin_amdgcn_exp2f(t)); }
__device__ __forceinline__ void phase_sgu_ln(Frame& F, const Args& a, int layer) {
    const bf16* PAC = (const bf16*)(a.ws + WS_P); bf16* Y = (bf16*)(a.ws + WS_Y);
    const float* lg = a.in[6] + layer * 512; const float* lb = a.in[7] + layer * 512;
    const int gw = F.vcu * NWAVES + F.wave, NGW = F.G * NWAVES, lane = F.lane;
    for (int m = gw; m < T; m += NGW) {
        const v4u w = *(const v4u*)(PAC + (size_t)m * N_AC + 2048 + lane * 8); float v[8];
#pragma unroll
        for (int j = 0; j < 4; ++j) { v[2 * j] = gelu_tanh(bflo(w[j])); v[2 * j + 1] = gelu_tanh(bfhi(w[j])); }
        float s = 0.f;
#pragma unroll
        for (int j = 0; j < 8; ++j) s += v[j];
        const float mu = wave_sum(s) * (1.f / 512.f); float s2 = 0.f;
#pragma unroll
        for (int j = 0; j < 8; ++j) { v[j] -= mu; s2 += v[j] * v[j]; }
        const float rstd = 1.f / sqrtf(wave_sum(s2) * (1.f / 512.f) + EPS);
        v4u o;
#pragma unroll
        for (int j = 0; j < 4; ++j) { const int c0 = lane * 8 + 2 * j; o[j] = pk2(v[2 * j] * rstd * lg[c0] + lb[c0], v[2 * j + 1] * rstd * lg[c0 + 1] + lb[c0 + 1]); }
        *(v4u*)(Y + (size_t)m * 1536 + 512 + lane * 8) = o;
    }
}
__device__ __forceinline__ void phase_sgu_mix(Frame& F, const Args& a, int layer) {
    const bf16* PAC = (const bf16*)(a.ws + WS_P); bf16* Y = (bf16*)(a.ws + WS_Y);
    const float* ws_ = a.in[8] + (size_t)layer * 4 * 128 * 128; const float* bs = a.in[9] + layer * 4 * 128;
    LAS bf16* vl = (LAS bf16*)F.lds;
    for (int ch = F.vcu; ch < T / 128; ch += F.G) {
        __syncthreads();
        for (int i = F.tid; i < 128 * 64; i += 512) { const int qq = i >> 6, c8 = i & 63; *(LAS v4u*)(vl + qq * 512 + c8 * 8) = *(const v4u*)(Y + ((size_t)ch * 128 + qq) * 1536 + 512 + c8 * 8); }
        __syncthreads();
        const int c = F.tid, g = c >> 7; const float* wg = ws_ + (size_t)g * 128 * 128;
#pragma unroll 1
        for (int p0 = 0; p0 < 128; p0 += 8) {
            float acc[8];
#pragma unroll
            for (int i = 0; i < 8; ++i) acc[i] = 0.f;
#pragma unroll 4
            for (int qq = 0; qq < 128; ++qq) { const float v = bf2f(vl[qq * 512 + c]);
#pragma unroll
                for (int i = 0; i < 8; ++i) acc[i] += wg[(p0 + i) * 128 + qq] * v; }
#pragma unroll
            for (int i = 0; i < 8; ++i) { const size_t tok = (size_t)ch * 128 + p0 + i; const float u = gelu_tanh(bf2f(PAC[tok * N_AC + 1536 + c]));
                Y[tok * 1536 + 1024 + c] = (bf16)f2bf(u * (acc[i] + bs[g * 128 + p0 + i])); }
        }
    }
    __syncthreads();
}
__device__ __forceinline__ s16x4 tr_read8(unsigned addr) { s16x4 r; asm volatile("ds_read_b64_tr_b16 %0, %1" : "=v"(r) : "v"(addr) : "memory"); return r; }
__device__ __forceinline__ void phase_sgu(Frame& F, const Args& a, int layer) {
    const bf16* PAC = (const bf16*)(a.ws + WS_P); bf16* Y = (bf16*)(a.ws + WS_Y);
    const float* lg = a.in[6] + layer * 512; const float* lb = a.in[7] + layer * 512; const float* bs = a.in[9] + layer * 4 * 128;
    const bf16* sgw = (const bf16*)(a.ws + WS_SGW) + (size_t)layer * 4 * 128 * 128;
    constexpr int RP = 1088; static_assert(128 * RP <= MISC_OFF, "SGU LDS image");
    const int lane = F.lane, wid = F.wave, r32 = lane & 31, hi = lane >> 5;
    for (int ch = F.vcu; ch < T / 128; ch += F.G) {
        __syncthreads();
        v4u wv16[16];
#pragma unroll
        for (int i = 0; i < 16; ++i) wv16[i] = *(const v4u*)(PAC + ((size_t)ch * 128 + wid * 16 + i) * N_AC + 2048 + lane * 8);
        const f32x4 g0 = *(const f32x4*)(lg + lane * 8), g1 = *(const f32x4*)(lg + lane * 8 + 4), b0 = *(const f32x4*)(lb + lane * 8), b1 = *(const f32x4*)(lb + lane * 8 + 4);
#pragma unroll
        for (int i = 0; i < 16; ++i) { const int qq = wid * 16 + i; const v4u w = wv16[i]; float v[8];
#pragma unroll
            for (int j = 0; j < 4; ++j) { v[2 * j] = gelu_tanh(bflo(w[j])); v[2 * j + 1] = gelu_tanh(bfhi(w[j])); }
            float s1 = 0.f;
#pragma unroll
            for (int j = 0; j < 8; ++j) s1 += v[j];
            const float mu = wave_sum(s1) * (1.f / 512.f); float s2 = 0.f;
#pragma unroll
            for (int j = 0; j < 8; ++j) { v[j] -= mu; s2 += v[j] * v[j]; }
            const float rstd = 1.f / sqrtf(wave_sum(s2) * (1.f / 512.f) + EPS);
            v4u o; o.x = pk2(v[0] * rstd * g0.x + b0.x, v[1] * rstd * g0.y + b0.y); o.y = pk2(v[2] * rstd * g0.z + b0.z, v[3] * rstd * g0.w + b0.w);
            o.z = pk2(v[4] * rstd * g1.x + b1.x, v[5] * rstd * g1.y + b1.y); o.w = pk2(v[6] * rstd * g1.z + b1.z, v[7] * rstd * g1.w + b1.w);
            *(LAS v4u*)(F.lds + qq * RP + lane * 16) = o; }
        __syncthreads();
        const int g = wid >> 1, p0 = (wid & 1) * 64;
        f32x16 acc[2][4];
#pragma unroll
        for (int i = 0; i < 2; ++i)
#pragma unroll
            for (int j = 0; j < 4; ++j) acc[i][j] = f32x16{};
        const int g16 = lane >> 4, i16 = lane & 15, tq = i16 >> 2, tp = i16 & 3;
        const unsigned vbase = (unsigned)(uintptr_t)F.lds + (unsigned)((8 * hi + tq) * RP + (g * 128 + 16 * (g16 & 1) + 4 * tp) * 2);
        const bf16* wa = sgw + ((size_t)g * 128 + p0 + r32) * 128 + hi * 8;
#pragma unroll 2
        for (int ks = 0; ks < 8; ++ks) {
            const bf16x8 a0 = *(const bf16x8*)(wa + ks * 16), a1 = *(const bf16x8*)(wa + 32 * 128 + ks * 16);
            s16x4 lo[4], hh[4];
#pragma unroll
            for (int ct = 0; ct < 4; ++ct) { lo[ct] = tr_read8(vbase + ks * 16 * RP + ct * 64); hh[ct] = tr_read8(vbase + ks * 16 * RP + 4 * RP + ct * 64); }
            LDS_WAIT(); __builtin_amdgcn_sched_barrier(0);
#pragma unroll
            for (int ct = 0; ct < 4; ++ct) { const bf16x8 vb = (bf16x8){lo[ct][0], lo[ct][1], lo[ct][2], lo[ct][3], hh[ct][0], hh[ct][1], hh[ct][2], hh[ct][3]};
                acc[0][ct] = __builtin_amdgcn_mfma_f32_32x32x16_bf16(vb, a0, acc[0][ct], 0, 0, 0);
                acc[1][ct] = __builtin_amdgcn_mfma_f32_32x32x16_bf16(vb, a1, acc[1][ct], 0, 0, 0); }
        }
        constexpr int EP = 1040;
        float bsv[2];
#pragma unroll
        for (int i = 0; i < 2; ++i) bsv[i] = bs[g * 128 + p0 + i * 32 + r32];
        __syncthreads();
        v4u uu[16];
#pragma unroll
        for (int i = 0; i < 16; ++i) uu[i] = *(const v4u*)(PAC + ((size_t)ch * 128 + wid * 16 + i) * N_AC + 1536 + lane * 8);
#pragma unroll
        for (int i = 0; i < 2; ++i) { LAS unsigned char* rowp = F.lds + (p0 + i * 32 + r32) * EP + (g * 128 + 4 * hi) * 2;
#pragma unroll
            for (int ct = 0; ct < 4; ++ct)
#pragma unroll
                for (int q4 = 0; q4 < 4; ++q4) { v2u w; w.x = pk2(acc[i][ct][4 * q4] + bsv[i], acc[i][ct][4 * q4 + 1] + bsv[i]); w.y = pk2(acc[i][ct][4 * q4 + 2] + bsv[i], acc[i][ct][4 * q4 + 3] + bsv[i]);
                    *(LAS v2u*)(rowp + (ct * 32 + 8 * q4) * 2) = w; } }
        __syncthreads();
#pragma unroll
        for (int i = 0; i < 16; ++i) { const int row = wid * 16 + i; const v4u d = *(const LAS v4u*)(F.lds + row * EP + lane * 16); const v4u u = uu[i]; v4u o;
#pragma unroll
            for (int j = 0; j < 4; ++j) o[j] = pk2(gelu_tanh(bflo(u[j])) * bflo(d[j]), gelu_tanh(bfhi(u[j])) * bfhi(d[j]));
            if (!a.dry) *(v4u*)(Y + ((size_t)ch * 128 + row) * 1536 + 1024 + lane * 8) = o; else asm volatile("" :: "v"(o)); }
    }
    __syncthreads();
}
__device__ __forceinline__ void phase_dilated(Frame& F, const Args& a) {
    bf16* PB = (bf16*)(a.ws + WS_P); float* LSE = (float*)(a.ws + WS_LIST);
    LAS float* tab = (LAS float*)F.lds;
    LAS unsigned char* vt = F.lds + 20480 + F.wave * 12288;
    { const float* btb = (const float*)(a.ws + WS_BTB); float tv_[9];
#pragma unroll
      for (int k = 0; k < 9; ++k) tv_[k] = btb[F.tid + 512 * k];
#pragma unroll
      for (int k = 0; k < 9; ++k) tab[F.tid + 512 * k] = tv_[k]; }
    __syncthreads();
    const int lane = F.lane, r32 = lane & 31, hi = lane >> 5;
    const int gw = F.vcu * NWAVES + F.wave, NGW = F.G * NWAVES;
    constexpr float C = 0.125f * LOG2E;
    const int g16 = lane >> 4, i16 = lane & 15, tq = i16 >> 2, tp = i16 & 3;
    const unsigned trb = (unsigned)(uintptr_t)vt + (unsigned)((8 * hi + tq) * 192 + (16 * (g16 & 1) + 4 * tp) * 2);
#pragma unroll 1
    for (int item = gw; item < BATCH * 3 * 8 * 128; item += NGW) {
        const int tix = item & 127, hh = (item >> 7) & 7, g = (item >> 10) % 3, b = item / (128 * 8 * 3);
        const int r = g == 0 ? 1 : (g == 1 ? 4 : 16), L = SEQ / r, tps = L / 32;
        const int s = tix / tps, qt = tix % tps;
        const int qcol = g * 512 + hh * 64;
        const int lbase = qt * 32 - 64;
        const bool edge = (lbase < 0) || (lbase + 160 > L);
        const char* base = sbase((const char*)(PB + ((size_t)b * SEQ + s) * N_B + qcol));
        const unsigned rs = (unsigned)r * (unsigned)(N_B * 2);
        bf16x8 qr[4], kf[5][4];
        { const unsigned qo = (unsigned)(qt * 32 + r32) * rs + (unsigned)hi * 16u;
#pragma unroll
          for (int d0 = 0; d0 < 4; ++d0) qr[d0] = *(const bf16x8*)(base + qo + d0 * 32); }
#pragma unroll
        for (int kt = 0; kt < 5; ++kt) { int lk = lbase + kt * 32 + r32; lk = lk < 0 ? 0 : (lk >= L ? L - 1 : lk);
            const unsigned ko = (unsigned)lk * rs + (unsigned)hi * 16u + 1536u * 2u;
#pragma unroll
            for (int d0 = 0; d0 < 4; ++d0) kf[kt][d0] = *(const bf16x8*)(base + ko + d0 * 32); }
        __builtin_amdgcn_sched_barrier(0);
        f32x16 p[5];
        { const LAS float* tb = tab + (g * 8 + hh) * 192 + 32 + 4 * hi - r32;
#pragma unroll
          for (int kt = 0; kt < 5; ++kt) {
#pragma unroll
            for (int rr = 0; rr < 16; ++rr) p[kt][rr] = tb[kt * 32 + (rr & 3) + 8 * (rr >> 2)]; } }
#pragma unroll
        for (int kt = 0; kt < 5; ++kt)
#pragma unroll
            for (int d0 = 0; d0 < 4; ++d0) p[kt] = __builtin_amdgcn_mfma_f32_32x32x16_bf16(kf[kt][d0], qr[d0], p[kt], 0, 0, 0);
        __builtin_amdgcn_sched_barrier(0);
        v4u vv[5][4];
#pragma unroll
        for (int kt = 0; kt < 5; ++kt)
#pragma unroll
            for (int j = 0; j < 4; ++j) { int lk = lbase + kt * 32 + j * 8 + (lane >> 3); lk = lk < 0 ? 0 : (lk >= L ? L - 1 : lk);
                vv[kt][j] = *(const v4u*)(base + ((unsigned)lk * rs + (unsigned)(lane & 7) * 16u + 3072u * 2u)); }
        __builtin_amdgcn_sched_barrier(0);
        if (edge) {
            asm volatile("" ::: "memory");
#pragma unroll
            for (int kt = 0; kt < 5; ++kt)
#pragma unroll
                for (int rr = 0; rr < 16; ++rr) { const int lk = lbase + kt * 32 + (rr & 3) + 8 * (rr >> 2) + 4 * hi; if (lk < 0 || lk >= L) p[kt][rr] = -1e30f; } }
        float mx = p[0][0];
#pragma unroll
        for (int kt = 0; kt < 5; ++kt)
#pragma unroll
            for (int rr = 0; rr < 16; ++rr) mx = fmaxf(mx, p[kt][rr]);
        { auto sw = __builtin_amdgcn_permlane32_swap(__float_as_uint(mx), __float_as_uint(mx), false, false); mx = fmaxf(__uint_as_float(sw[0]), __uint_as_float(sw[1])); }
        const float mxc = -mx * C; float ls = 0.f;
#pragma unroll
        for (int kt = 0; kt < 5; ++kt)
#pragma unroll
            for (int rr = 0; rr < 16; ++rr) { const float e = __builtin_amdgcn_exp2f(fmaf(p[kt][rr], C, mxc)); p[kt][rr] = e; ls += e; }
        { auto sw = __builtin_amdgcn_permlane32_swap(__float_as_uint(ls), __float_as_uint(ls), false, false); ls = __uint_as_float(sw[0]) + __uint_as_float(sw[1]); }
        bf16x8 pa[5][2];
#define PK4(P, BASE, OUT) do { unsigned a0 = cvt_pk_bf16(P[BASE + 0], P[BASE + 1]), a1 = cvt_pk_bf16(P[BASE + 2], P[BASE + 3]);   \
    unsigned b0 = cvt_pk_bf16(P[BASE + 4], P[BASE + 5]), b1 = cvt_pk_bf16(P[BASE + 6], P[BASE + 7]);                              \
    auto r0 = __builtin_amdgcn_permlane32_swap(a0, b0, false, false); auto r1 = __builtin_amdgcn_permlane32_swap(a1, b1, false, false); \
    v4u w_ = {r0[0], r1[0], r0[1], r1[1]}; OUT = __builtin_bit_cast(bf16x8, w_); } while (0)
#pragma unroll
        for (int kt = 0; kt < 5; ++kt) { PK4(p[kt], 0, pa[kt][0]); PK4(p[kt], 8, pa[kt][1]); }
#undef PK4
        __builtin_amdgcn_sched_barrier(0);
        f32x16 o0 = {}, o1 = {};
#define VWRITE(kt, buf) do { _Pragma("unroll") for (int j = 0; j < 4; ++j) { const int key = j * 8 + (lane >> 3), chk = lane & 7; *(LAS v4u*)(vt + (buf) * 6144 + key * 192 + chk * 16) = vv[kt][j]; } } while (0)
#define VPV(kt, buf) do { _Pragma("unroll") for (int ks = 0; ks < 2; ++ks) { const unsigned ba_ = trb + (buf) * 6144 + ks * 16 * 192; \
        const s16x4 l0 = tr_read8(ba_), h0 = tr_read8(ba_ + 4 * 192), l1 = tr_read8(ba_ + 64), h1 = tr_read8(ba_ + 4 * 192 + 64); \
        LDS_WAIT(); __builtin_amdgcn_sched_barrier(0); \
        const bf16x8 vb0 = (bf16x8){l0[0], l0[1], l0[2], l0[3], h0[0], h0[1], h0[2], h0[3]}; const bf16x8 vb1 = (bf16x8){l1[0], l1[1], l1[2], l1[3], h1[0], h1[1], h1[2], h1[3]}; \
        o0 = __builtin_amdgcn_mfma_f32_32x32x16_bf16(vb0, pa[kt][ks], o0, 0, 0, 0); o1 = __builtin_amdgcn_mfma_f32_32x32x16_bf16(vb1, pa[kt][ks], o1, 0, 0, 0); } } while (0)
        VWRITE(0, 0); VWRITE(1, 1); LDS_WAIT(); VPV(0, 0); VPV(1, 1);
        LDS_WAIT(); VWRITE(2, 0); VWRITE(3, 1); LDS_WAIT(); VPV(2, 0); VPV(3, 1);
        LDS_WAIT(); VWRITE(4, 0); LDS_WAIT(); VPV(4, 0);
#undef VWRITE
#undef VPV
        if (a.dry) { asm volatile("" :: "v"(o0[0]), "v"(o1[5]), "v"(mx)); continue; }
        if (hi == 0) LSE[((size_t)g * T + (size_t)b * SEQ + (size_t)(qt * 32 + r32) * r + s) * 8 + hh] = mx * C + __builtin_amdgcn_logf(ls);
        { const float il = __builtin_amdgcn_rcpf(ls); LAS unsigned char* ost = vt + r32 * 144 + hi * 8;
#pragma unroll
          for (int q4 = 0; q4 < 4; ++q4) { v2u w0, w1;
            w0.x = pk2(o0[4 * q4] * il, o0[4 * q4 + 1] * il); w0.y = pk2(o0[4 * q4 + 2] * il, o0[4 * q4 + 3] * il);
            w1.x = pk2(o1[4 * q4] * il, o1[4 * q4 + 1] * il); w1.y = pk2(o1[4 * q4 + 2] * il, o1[4 * q4 + 3] * il);
            *(LAS v2u*)(ost + q4 * 16) = w0; *(LAS v2u*)(ost + 64 + q4 * 16) = w1; }
          LDS_WAIT();
#pragma unroll
          for (int ps = 0; ps < 4; ++ps) { const int row = ps * 8 + (lane >> 3); const v4u v = *(const LAS v4u*)(vt + row * 144 + (lane & 7) * 16);
            *(v4u*)((char*)base + ((unsigned)(qt * 32 + row) * rs + (unsigned)(lane & 7) * 16u)) = v; } }
        LDS_WAIT();
    }
    __syncthreads();
}
__device__ __forceinline__ void phase_dilated2(Frame& F, const Args& a) {
    bf16* PB = (bf16*)(a.ws + WS_P); float* LSE = (float*)(a.ws + WS_LIST); const float* btb = (const float*)(a.ws + WS_BTB);
    constexpr int D2_TAB = 0, D2_K = 2048, D2_V = D2_K + 384 * 128, D2_O = D2_V + 384 * 128;
    static_assert(D2_O + 8 * 4608 <= MISC_OFF, "dilated LDS map");
    const int lane = F.lane, wid = F.wave, r32 = lane & 31, hi = lane >> 5;
    constexpr float C = 0.125f * LOG2E;
    LAS unsigned char* KL = F.lds + D2_K; LAS unsigned char* VL = F.lds + D2_V; LAS unsigned char* ost = F.lds + D2_O + wid * 4608;
    int kro[4];
#pragma unroll
    for (int d0 = 0; d0 < 4; ++d0) kro[d0] = (int)(uintptr_t)KL + wid * 4096 + r32 * 128 + (((2 * d0 + hi) ^ ((r32 >> 1) & 7)) << 4);
    const int i16 = lane & 15, g16 = lane >> 4;
    const int vrd = (int)(uintptr_t)VL + (4 * wid + hi) * 1024 + (i16 >> 2) * 64 + (i16 & 3) * 8 + (g16 & 1) * 32;
    const int kR0 = wid * 48 + (lane >> 3), vR0 = wid * 48 + ((lane >> 2) & 7);
    const unsigned vcb = (unsigned)(((lane >> 5) & 1) * 64 + (lane & 3) * 16);
    int t_next = F.vcu;
    bf16x8 qr[4]; float tabv = 0.f;
#define D2_DECODE(IT, g_, hh_, b_, s_, blk_, r_, L_) const int t16_ = (IT) & 15, hh_ = ((IT) >> 4) & 7, g_ = ((IT) >> 7) % 3, b_ = (IT) / 384; \
        const int r_ = g_ == 0 ? 1 : (g_ == 1 ? 4 : 16), L_ = SEQ / r_, nb_ = L_ >> 8, s_ = t16_ / nb_, blk_ = t16_ % nb_
#define D2_ISSUE_KQT(IT) do { D2_DECODE(IT, g_, hh_, b_, s_, blk_, r_, L_); const unsigned rs_ = (unsigned)r_ * (unsigned)(N_B * 2); \
        const char* bs_ = sbase((const char*)(PB + ((size_t)b_ * SEQ + s_) * N_B + g_ * 512 + hh_ * 64)); const int lw0_ = blk_ * 256 - 64; \
        _Pragma("unroll") for (int j = 0; j < 6; ++j) { const int R_ = kR0 + 8 * j; int lk_ = lw0_ + R_; lk_ = lk_ < 0 ? 0 : (lk_ >= L_ ? L_ - 1 : lk_); \
            const unsigned so_ = (unsigned)lk_ * rs_ + 1536u * 2u + (unsigned)((((lane & 7) ^ ((R_ >> 1) & 7))) << 4); \
            __builtin_amdgcn_global_load_lds((const unsigned*)(bs_ + so_), (LAS unsigned*)(KL + (wid * 6 + j) * 1024), 16, 0, 0); } \
        { const unsigned qo_ = (unsigned)(blk_ * 256 + wid * 32 + r32) * rs_ + (unsigned)hi * 16u; \
          _Pragma("unroll") for (int d0 = 0; d0 < 4; ++d0) qr[d0] = *(const bf16x8*)(bs_ + qo_ + d0 * 32); } \
        tabv = btb[(g_ * 8 + hh_) * 192 + (F.tid < 192 ? F.tid : 0)]; } while (0)
#define D2_ISSUE_V(IT) do { D2_DECODE(IT, g_, hh_, b_, s_, blk_, r_, L_); const unsigned rs_ = (unsigned)r_ * (unsigned)(N_B * 2); \
        const char* bs_ = sbase((const char*)(PB + ((size_t)b_ * SEQ + s_) * N_B + g_ * 512 + hh_ * 64)); const int lw0_ = blk_ * 256 - 64; \
        _Pragma("unroll") for (int j = 0; j < 6; ++j) { int lk_ = lw0_ + vR0 + 8 * j; lk_ = lk_ < 0 ? 0 : (lk_ >= L_ ? L_ - 1 : lk_); \
            __builtin_amdgcn_global_load_lds((const unsigned*)(bs_ + ((unsigned)lk_ * rs_ + 3072u * 2u + vcb)), (LAS unsigned*)(VL + (wid * 6 + j) * 1024), 16, 0, 0); } } while (0)
    if (t_next < BATCH * 3 * 8 * 16) { D2_ISSUE_KQT(t_next); __builtin_amdgcn_sched_barrier(0); D2_ISSUE_V(t_next); }
    asm volatile("s_waitcnt vmcnt(0)" ::: "memory");
    int par = 0;
#pragma unroll 1
    for (int item = F.vcu; item < BATCH * 3 * 8 * 16; item += F.G) {
        D2_DECODE(item, g, hh, b, s, blk, r, L);
        const unsigned rs = (unsigned)r * (unsigned)(N_B * 2);
        const char* base = sbase((const char*)(PB + ((size_t)b * SEQ + s) * N_B + g * 512 + hh * 64));
        const int lbase = blk * 256 + wid * 32 - 64;
        const bool edge = (lbase < 0) || (lbase + 160 > L);
        LAS float* tab = (LAS float*)(F.lds + D2_TAB + par * 768);
        if (a.dry) asm volatile("s_waitcnt vmcnt(0)" ::: "memory"); else asm volatile("s_waitcnt vmcnt(11)" ::: "memory");
        if (F.tid < 192) tab[F.tid] = tabv;
        asm volatile("s_waitcnt lgkmcnt(0)" ::: "memory"); __builtin_amdgcn_s_barrier(); asm volatile("" ::: "memory");
        f32x16 p[5];
        { const LAS float* tb = tab + 32 + 4 * hi - r32;
#pragma unroll
          for (int kt = 0; kt < 5; ++kt) {
#pragma unroll
            for (int rr = 0; rr < 16; ++rr) p[kt][rr] = tb[kt * 32 + (rr & 3) + 8 * (rr >> 2)]; } }
#pragma unroll
        for (int kt = 0; kt < 5; ++kt) { bf16x8 kf[4];
#pragma unroll
            for (int d0 = 0; d0 < 4; ++d0) kf[d0] = *(const LAS bf16x8*)(uintptr_t)(unsigned)(kro[d0] + kt * 4096);
#pragma unroll
            for (int d0 = 0; d0 < 4; ++d0) p[kt] = __builtin_amdgcn_mfma_f32_32x32x16_bf16(kf[d0], qr[d0], p[kt], 0, 0, 0); }
        asm volatile("s_waitcnt vmcnt(0) lgkmcnt(0)" ::: "memory"); __builtin_amdgcn_s_barrier(); asm volatile("" ::: "memory");
        __builtin_amdgcn_sched_barrier(0);
        { const int nx = item + F.G < BATCH * 3 * 8 * 16 ? item + F.G : item; D2_ISSUE_KQT(nx); }
        __builtin_amdgcn_sched_barrier(0);
        if (edge) {
            asm volatile("" ::: "memory");
#pragma unroll
            for (int kt = 0; kt < 5; ++kt)
#pragma unroll
                for (int rr = 0; rr < 16; ++rr) { const int lk = lbase + kt * 32 + (rr & 3) + 8 * (rr >> 2) + 4 * hi; if (lk < 0 || lk >= L) p[kt][rr] = -1e30f; } }
        float mx = p[0][0];
#pragma unroll
        for (int kt = 0; kt < 5; ++kt)
#pragma unroll
            for (int rr = 0; rr < 16; ++rr) mx = fmaxf(mx, p[kt][rr]);
        { auto sw = __builtin_amdgcn_permlane32_swap(__float_as_uint(mx), __float_as_uint(mx), false, false); mx = fmaxf(__uint_as_float(sw[0]), __uint_as_float(sw[1])); }
        const float mxc = -mx * C; float ls = 0.f;
#pragma unroll
        for (int kt = 0; kt < 5; ++kt)
#pragma unroll
            for (int rr = 0; rr < 16; ++rr) { const float e = __builtin_amdgcn_exp2f(fmaf(p[kt][rr], C, mxc)); p[kt][rr] = e; ls += e; }
        { auto sw = __builtin_amdgcn_permlane32_swap(__float_as_uint(ls), __float_as_uint(ls), false, false); ls = __uint_as_float(sw[0]) + __uint_as_float(sw[1]); }
        bf16x8 pa[5][2];
#define PK4(P, BASE, OUT) do { unsigned a0 = cvt_pk_bf16(P[BASE + 0], P[BASE + 1]), a1 = cvt_pk_bf16(P[BASE + 2], P[BASE + 3]);   \
    unsigned b0 = cvt_pk_bf16(P[BASE + 4], P[BASE + 5]), b1 = cvt_pk_bf16(P[BASE + 6], P[BASE + 7]);                              \
    auto r0 = __builtin_amdgcn_permlane32_swap(a0, b0, false, false); auto r1 = __builtin_amdgcn_permlane32_swap(a1, b1, false, false); \
    v4u w_ = {r0[0], r1[0], r0[1], r1[1]}; OUT = __builtin_bit_cast(bf16x8, w_); } while (0)
#pragma unroll
        for (int kt = 0; kt < 5; ++kt) { PK4(p[kt], 0, pa[kt][0]); PK4(p[kt], 8, pa[kt][1]); }
#undef PK4
        __builtin_amdgcn_sched_barrier(0);
        f32x16 o0 = {}, o1 = {};
#define D2_VF(kt, ks, cb, LO, HI4) do { LO = da::tr_read<((4 * (kt) + 2 * (ks)) * 1024 + (cb) * 512)>(vrd); HI4 = da::tr_read<((4 * (kt) + 2 * (ks)) * 1024 + (cb) * 512 + 256)>(vrd); } while (0)
#define D2_PKV(L_, H_) (bf16x8){L_[0], L_[1], L_[2], L_[3], H_[0], H_[1], H_[2], H_[3]}
#define D2_TILE(kt) do { s16x4 l00, h00, l01, h01, l10, h10, l11, h11; D2_VF(kt, 0, 0, l00, h00); D2_VF(kt, 0, 1, l01, h01); D2_VF(kt, 1, 0, l10, h10); D2_VF(kt, 1, 1, l11, h11); \
            LDS_WAIT(); __builtin_amdgcn_sched_barrier(0); \
            o0 = __builtin_amdgcn_mfma_f32_32x32x16_bf16(D2_PKV(l00, h00), pa[kt][0], o0, 0, 0, 0); o1 = __builtin_amdgcn_mfma_f32_32x32x16_bf16(D2_PKV(l01, h01), pa[kt][0], o1, 0, 0, 0); \
            o0 = __builtin_amdgcn_mfma_f32_32x32x16_bf16(D2_PKV(l10, h10), pa[kt][1], o0, 0, 0, 0); o1 = __builtin_amdgcn_mfma_f32_32x32x16_bf16(D2_PKV(l11, h11), pa[kt][1], o1, 0, 0, 0); } while (0)
        D2_TILE(0); D2_TILE(1); D2_TILE(2); D2_TILE(3); D2_TILE(4);
#undef D2_TILE
#undef D2_PKV
#undef D2_VF
        asm volatile("s_waitcnt lgkmcnt(0)" ::: "memory"); __builtin_amdgcn_s_barrier(); asm volatile("" ::: "memory");
        __builtin_amdgcn_sched_barrier(0);
        { const int nx = item + F.G < BATCH * 3 * 8 * 16 ? item + F.G : item; D2_ISSUE_V(nx); }
        __builtin_amdgcn_sched_barrier(0);
        par ^= 1;
        if (a.dry) { asm volatile("" :: "v"(o0[0]), "v"(o1[5]), "v"(mx)); continue; }
        if (hi == 0) LSE[((size_t)g * T + (size_t)b * SEQ + (size_t)(blk * 256 + wid * 32 + r32) * r + s) * 8 + hh] = mx * C + __builtin_amdgcn_logf(ls);
        { const float il = __builtin_amdgcn_rcpf(ls); LAS unsigned char* op = ost + r32 * 144 + hi * 8;
#pragma unroll
          for (int q4 = 0; q4 < 4; ++q4) { v2u w0, w1;
            w0.x = pk2(o0[4 * q4] * il, o0[4 * q4 + 1] * il); w0.y = pk2(o0[4 * q4 + 2] * il, o0[4 * q4 + 3] * il);
            w1.x = pk2(o1[4 * q4] * il, o1[4 * q4 + 1] * il); w1.y = pk2(o1[4 * q4 + 2] * il, o1[4 * q4 + 3] * il);
            *(LAS v2u*)(op + q4 * 16) = w0; *(LAS v2u*)(op + 64 + q4 * 16) = w1; }
          LDS_WAIT();
#pragma unroll
          for (int ps = 0; ps < 4; ++ps) { const int row = ps * 8 + (lane >> 3); const v4u v = *(const LAS v4u*)(ost + row * 144 + (lane & 7) * 16);
            *(v4u*)((char*)base + ((unsigned)(blk * 256 + wid * 32 + row) * rs + (unsigned)(lane & 7) * 16u)) = v; } }
        LDS_WAIT();
    }
    asm volatile("s_waitcnt vmcnt(0)" ::: "memory");
    __syncthreads();
#undef D2_DECODE
#undef D2_ISSUE_KQT
#undef D2_ISSUE_V
}
__device__ __forceinline__ void phase_dilated_combine(Frame& F, const Args& a) {
    const bf16* PB = (const bf16*)(a.ws + WS_P); const float* LSE = (const float*)(a.ws + WS_LIST); bf16* Y = (bf16*)(a.ws + WS_Y);
    const int gw = F.vcu * NWAVES + F.wave, NGW = F.G * NWAVES, lane = F.lane, hh = lane >> 3;
#pragma unroll 1
    for (int m0 = gw; m0 < T; m0 += 4 * NGW) {
        float ls[4][3]; v4u ov[4][3];
#pragma unroll
        for (int u = 0; u < 4; ++u) { const int m = m0 + u * NGW < T ? m0 + u * NGW : m0;
#pragma unroll
            for (int g = 0; g < 3; ++g) { ls[u][g] = LSE[((size_t)g * T + m) * 8 + hh]; ov[u][g] = *(const v4u*)(PB + (size_t)m * N_B + g * 512 + lane * 8); } }
#pragma unroll
        for (int u = 0; u < 4; ++u) { const int m = m0 + u * NGW; if (m >= T) break;
            const float l0 = ls[u][0], l1 = ls[u][1], l2 = ls[u][2];
            const float mx = fmaxf(l0, fmaxf(l1, l2)); const float e0 = __builtin_amdgcn_exp2f(l0 - mx), e1 = __builtin_amdgcn_exp2f(l1 - mx), e2 = __builtin_amdgcn_exp2f(l2 - mx);
            const float inv = 1.f / (e0 + e1 + e2); const float w[3] = {e0 * inv, e1 * inv, e2 * inv};
            float y[8];
#pragma unroll
            for (int j = 0; j < 8; ++j) y[j] = 0.f;
#pragma unroll
            for (int g = 0; g < 3; ++g) { const v4u uu = ov[u][g];
#pragma unroll
                for (int j = 0; j < 4; ++j) { y[2 * j] += w[g] * bflo(uu[j]); y[2 * j + 1] += w[g] * bfhi(uu[j]); } }
            v4u o; o.x = pk2(y[0], y[1]); o.y = pk2(y[2], y[3]); o.z = pk2(y[4], y[5]); o.w = pk2(y[6], y[7]);
            *(v4u*)(Y + (size_t)m * 1536 + 512 + lane * 8) = o; }
    }
}

constexpr int PH_PER_LAYER = 14, N_PHASES = 1 + DEPTH * PH_PER_LAYER;
template <int VAR> __global__ void __launch_bounds__(NWAVES * 64, 2) fwd(Args args) {
    extern __shared__ __attribute__((aligned(16))) unsigned char lds_raw[];
    Frame F;
    F.lds = (LAS unsigned char*)lds_raw; F.MISC = (volatile LAS unsigned*)(F.lds + MISC_OFF);
    F.tid = threadIdx.x; F.lane = F.tid & 63; F.wave = __builtin_amdgcn_readfirstlane(F.tid >> 6);
    F.G = gridDim.x; { const int bx = blockIdx.x; F.vcu = (F.G % 8 == 0) ? (bx % 8) * (F.G / 8) + bx / 8 : bx; }
    F.ctl = (unsigned*)(args.ws + WS_CTL);
    for (int u = F.tid; u < (LDS_BYTES - MISC_OFF) / 4; u += NWAVES * 64) ((LAS unsigned*)(F.lds + MISC_OFF))[u] = 0u;
    __syncthreads();
    XcdBarrier bar; bar.bar = F.ctl + CW_BAR; bar.x = 0; bar.st = nullptr;
#if MK_ONE_LAUNCH
    bar = xcd_barrier_post(F.ctl + CW_BAR, F.MISC + 8);
#define GRID_BAR() do { asm volatile("" : "+s"(bar.bar), "+s"(bar.x)); xcd_barrier(bar); } while (0)
#else
#define GRID_BAR() do {} while (0)
#endif
    const int lo = args.ph_lo, hi = args.ph_hi;
#define IN(k) (lo <= (k) && (k) < hi)
#define PB() do { int t_ = threadIdx.x; asm volatile("" : "+v"(t_)); F.tid = t_; F.lane = t_ & 63; { size_t z_ = 0; asm volatile("" : "+s"(z_)); args.ws += z_; args.out += z_; } } while (0)
#define SEAM(k) do { if (IN(k) && IN((k) + 1)) GRID_BAR(); } while (0)
#define WS_ (args.ws)
#define H_ ((bf16*)(args.ws + WS_H))
#define Y_ ((bf16*)(args.ws + WS_Y))
#define P_ ((bf16*)(args.ws + WS_P))
#define X_ (args.out)

    if (IN(0) && PHE(100)) { PB(); convert_mixer_weights(F, args, 0); build_bias_tables(F, args); phase_norm(F, args.in[0], args.in[2], H_, WS_ + WS_H8); }
    SEAM(0);
#pragma unroll 1
    for (int layer = 0; layer < DEPTH; ++layer) {
        const int pb = 1 + layer * PH_PER_LAYER;
        if (IN(pb + 0) && PHE(0)) { PB(); PInProj<false> p; p.A = (const char*)H_; p.B = (const char*)(WS_ + WS_WIN); p.nM = T / 256; p.nN = N_AC / 256; p.G = F.G; p.c = blockIdx.x; p.O = P_; p.ldc = N_AC; pg8::gemm_phase(F.lds, p); }
        SEAM(pb + 0);
        if (IN(pb + 1) && PHE(1)) { PB(); phase_attnA<VAR>(F, args, layer); }
        if (IN(pb + 2) && PHE(2)) { PB(); phase_sgu(F, args, layer); }
        SEAM(pb + 2);
        if (IN(pb + 3) && PHE(3)) { PB();
            { PInProj<false> p; p.A = (const char*)H_; p.B = (const char*)(WS_ + WS_WIN) + (size_t)N_AC * 1024 * 2; p.nM = T / 256; p.nN = 12; p.G = F.G; p.c = blockIdx.x; p.O = P_; p.ldc = N_B; pg8::gemm_phase(F.lds, p); }
            { PInProj<false, true> p; p.A = (const char*)(WS_ + WS_H8); p.B = (const char*)(WS_ + WS_WIN) + (size_t)(N_AC + N_B) * 1024 * 2 + (size_t)4608 * 1024; p.nM = T / 256; p.nN = 6; p.G = F.G; p.c = blockIdx.x; p.O = P_ + 3072; p.ldc = N_B; pg8::gemm_phase(F.lds, p); } }
        SEAM(pb + 3);
        if (IN(pb + 4) && PHE(4)) { PB(); phase_dilated2(F, args); }
        SEAM(pb + 4);
        if (IN(pb + 5) && PHE(5)) { PB(); phase_dilated_combine(F, args); }
        SEAM(pb + 5);
        if (IN(pb + 6) && PHE(6)) { PB(); PInProj<true, true> p; p.A = (const char*)(WS_ + WS_H8); p.B = (const char*)(WS_ + WS_WIN) + (size_t)(N_AC + N_B) * 1024 * 2; p.nM = T / 256; p.nN = N_G / 256; p.G = F.G; p.c = blockIdx.x; p.O = P_; p.ldc = N_G; pg8::gemm_phase(F.lds, p); }
        SEAM(pb + 6);
        if (IN(pb + 7) && PHE(7)) { PB(); PMerge p; p.A = (const char*)Y_; p.B = (const char*)(WS_ + WS_WBR); p.nM = T / 256; p.nN = 4; p.G = F.G; p.c = blockIdx.x; p.PG = P_; p.O = H_; pg8::gemm_phase(F.lds, p); }
        SEAM(pb + 7);
        if (IN(pb + 8) && PHE(8)) { PB(); POut p; p.A = (const char*)H_; p.B = (const char*)(WS_ + WS_WOUT); p.nM = T / 256; p.nN = 4; p.G = F.G; p.c = blockIdx.x; p.base = layer == 0 ? args.in[0] : X_; p.X = X_; pg8::gemm_phase(F.lds, p); }
        SEAM(pb + 8);
        if (IN(pb + 9) && PHE(9)) { PB(); phase_router(F, args, layer, X_, H_); }
        if (IN(pb + 10) && PHE(10)) { PB(); convert_expert_weights(F, args, layer); if (layer + 1 < DEPTH) convert_mixer_weights(F, args, layer + 1); }
        SEAM(pb + 10);
        if (IN(pb + 11) && PHE(11)) { PB(); moe_table(F, layer); PGateUp p; p.tp = (const volatile LAS int*)(F.MISC + 16); p.list = (const int*)(WS_ + WS_LIST); p.tw = (const float*)(WS_ + WS_TW); p.ncol = 8; p.G = F.G; p.c = F.vcu;
            p.A = (const char*)H_; p.W = (const char*)(WS_ + WS_WGU); p.hid = (unsigned char*)P_; pg8::gemm_phase(F.lds, p); }
        SEAM(pb + 11);
        if (IN(pb + 12) && PHE(12)) { PB(); moe_table(F, layer); PDown p; p.tp = (const volatile LAS int*)(F.MISC + 16); p.list = (const int*)(WS_ + WS_LIST); p.tw = (const float*)(WS_ + WS_TW); p.ncol = 4; p.G = F.G; p.c = F.vcu;
            p.A = (const char*)P_; p.W = (const char*)(WS_ + WS_WD); p.X = X_; p.dry = args.dry; pg8::gemm_phase(F.lds, p); }
        SEAM(pb + 12);
        if (IN(pb + 13) && PHE(13)) { PB(); if (layer + 1 < DEPTH) phase_norm(F, X_, args.in[2] + (size_t)(layer + 1) * DM, H_, WS_ + WS_H8); else phase_final_norm(F, X_, args.in[20]); }
        SEAM(pb + 13);
    }
}

extern "C" void kernel_launch(void* const* d_in, const int* in_sizes, int n_in, void* d_out, int out_size, void* d_ws, size_t ws_size, hipStream_t stream) {
    static int grid = 0;
    if (grid == 0) {
        if (n_in != 21 || out_size != T * DM || ws_size < WS_END) { fprintf(stderr, "kernel_launch: unexpected shapes: n_in %d out %d ws %zu (need %zu)\n", n_in, out_size, ws_size, (size_t)WS_END); grid = -1; return; }
        int dev = 0, cus = 0;
        if (hipGetDevice(&dev) != hipSuccess || hipDeviceGetAttribute(&cus, hipDeviceAttributeMultiprocessorCount, dev) != hipSuccess) { grid = -1; return; }
        if (hipFuncSetAttribute((const void*)fwd<0>, hipFuncAttributeMaxDynamicSharedMemorySize, LDS_BYTES) != hipSuccess || hipFuncSetAttribute((const void*)fwd<PROBE_VAR>, hipFuncAttributeMaxDynamicSharedMemorySize, LDS_BYTES) != hipSuccess) { fprintf(stderr, "kernel_launch: hipFuncSetAttribute failed\n"); grid = -1; return; }
        int per_cu = 0; (void)hipOccupancyMaxActiveBlocksPerMultiprocessor(&per_cu, (const void*)fwd<0>, NWAVES * 64, LDS_BYTES); (void)hipGetLastError();
        grid = cus;
    }
    if (grid < 0) return;
    if (hipMemsetAsync((char*)d_ws + WS_CTL, 0, CTL_ZERO_BYTES, stream) != hipSuccess) return;
    Args a{};
    for (int i = 0; i < 21; ++i) a.in[i] = (const float*)d_in[i];
    a.out = (float*)d_out; a.ws = (unsigned char*)d_ws;
#if MK_ONE_LAUNCH
    a.ph_lo = 0; a.ph_hi = N_PHASES;
    hipLaunchKernelGGL(fwd<0>, dim3(grid), dim3(NWAVES * 64), LDS_BYTES, stream, a);
#else
    for (int ph = 0; ph < N_PHASES; ++ph) { a.ph_lo = ph; a.ph_hi = ph + 1; const int k = ph == 0 ? 31 : (ph - 1) % PH_PER_LAYER; const int nrep = ((HOST_DUPMASK >> k) & 1) ? 2 : 1;
        for (int r = 0; r < nrep; ++r) { a.dry = r; if (r == 0) hipLaunchKernelGGL(fwd<0>, dim3(grid), dim3(NWAVES * 64), LDS_BYTES, stream, a); else hipLaunchKernelGGL(fwd<PROBE_VAR>, dim3(grid), dim3(NWAVES * 64), LDS_BYTES, stream, a); } }
#endif
}
```

```cpp
#include <hip/hip_runtime.h>
#include <cstdio>
#include <cstdint>

#ifndef MK_ONE_LAUNCH
#define MK_ONE_LAUNCH 1
#endif
#ifndef ONLY_PHASE
#define ONLY_PHASE -1
#endif
#define PHE(k) (ONLY_PHASE < 0 || ONLY_PHASE == (k))
#ifndef PROBE_VAR
#define PROBE_VAR 0
#endif
#ifndef HOST_DUPMASK
#define HOST_DUPMASK 0
#endif

constexpr int BATCH = 8, SEQ = 4096, DM = 1024, T = BATCH * SEQ, DEPTH = 2;
constexpr int D_IN = 10240, N_AC = 2560, N_B = 4608, N_G = 3072;
constexpr int NEXP = 16, DFF = 512, NBUCKET = 24, LISTCAP = 32768;
constexpr float EPS = 1e-6f;
constexpr float LOG2E = 1.4426950408889634f;
constexpr float da_QSC = 0.125f * LOG2E;

constexpr size_t MiB = 1u << 20;
constexpr size_t WS_CTL = 0, CTL_ZERO_BYTES = 64 * 1024;
constexpr size_t WS_BTA = 1 * MiB;
constexpr size_t WS_BTB = WS_BTA + 4 * 8192 * 4;
constexpr size_t WS_SGW = WS_BTA + 512 * 1024;
constexpr size_t WS_WIN = 2 * MiB;
constexpr size_t WS_WBR = 22 * MiB;
constexpr size_t WS_WOUT = 25 * MiB;
constexpr size_t WS_LIST = 27 * MiB;
constexpr size_t WS_TW = 30 * MiB;
constexpr size_t WS_H = 32 * MiB;
constexpr size_t WS_Y = 96 * MiB;
constexpr size_t WS_WGU = WS_Y, WS_WD = WS_Y + 32 * MiB;
constexpr size_t WS_P = 192 * MiB;
constexpr size_t WS_OA = WS_P + 160 * MiB;
constexpr size_t WS_H8 = 480 * MiB;
constexpr size_t WS_END = 512 * MiB;
constexpr int CW_BAR = 4096, CW_CNT = 8192;

constexpr int RING_BYTES = 131072, LDS_BYTES = 147456, MISC_OFF = LDS_BYTES - 1024;
constexpr int NWAVES = 8;

#define GAS __attribute__((address_space(1)))
#define LAS __attribute__((address_space(3)))
typedef unsigned short bf16;
typedef unsigned v4u __attribute__((ext_vector_type(4)));
typedef unsigned v2u __attribute__((ext_vector_type(2)));
typedef float f32x4 __attribute__((ext_vector_type(4)));
typedef float f32x16 __attribute__((ext_vector_type(16)));
typedef short bf16x8 __attribute__((ext_vector_type(8)));
typedef short s16x4 __attribute__((ext_vector_type(4)));
#define LDS_WAIT() asm volatile("s_waitcnt lgkmcnt(0)" ::: "memory")
#define VM_WAIT() asm volatile("s_waitcnt vmcnt(0)" ::: "memory")
__device__ __forceinline__ unsigned f2bf(float f) { unsigned u = __builtin_bit_cast(unsigned, f); return (u + 0x7fffu + ((u >> 16) & 1u)) >> 16; }
__device__ __forceinline__ float bf2f(unsigned b) { return __builtin_bit_cast(float, b << 16); }
__device__ __forceinline__ float bflo(unsigned w) { return __builtin_bit_cast(float, w << 16); }
__device__ __forceinline__ float bfhi(unsigned w) { return __builtin_bit_cast(float, w & 0xffff0000u); }
typedef float f32x2_t __attribute__((ext_vector_type(2))); typedef __bf16 bf16x2_t __attribute__((ext_vector_type(2)));
__device__ __forceinline__ unsigned pk2(float lo, float hi) { f32x2_t v = {lo, hi}; bf16x2_t b = __builtin_convertvector(v, bf16x2_t); return __builtin_bit_cast(unsigned, b); }
__device__ __forceinline__ unsigned cvt_pk_bf16(float lo, float hi) { f32x2_t v = {lo, hi}; bf16x2_t b = __builtin_convertvector(v, bf16x2_t); return __builtin_bit_cast(unsigned, b); }
__device__ __forceinline__ unsigned pk4_fp8(float a, float b, float c, float d) { unsigned w = 0; w = __builtin_amdgcn_cvt_pk_fp8_f32(a, b, w, false); w = __builtin_amdgcn_cvt_pk_fp8_f32(c, d, w, true); return w; }
__device__ __forceinline__ const char* sbase(const char* p) { size_t z = 0; asm volatile("" : "+s"(z)); return p + z; }
__device__ __forceinline__ int crow(int r, int hi) { return (r & 3) + 8 * (r >> 2) + 4 * hi; }
template <int M> __device__ __forceinline__ float swz_xor(float v) { return __builtin_bit_cast(float, __builtin_amdgcn_ds_swizzle(__builtin_bit_cast(int, v), (M << 10) | 0x1F)); }
template <int CTRL, int ROWS> __device__ __forceinline__ float dpp_add(float x) { return x + __builtin_bit_cast(float, __builtin_amdgcn_update_dpp(0, __builtin_bit_cast(int, x), CTRL, ROWS, 0xF, false)); }
__device__ __forceinline__ float row_sums(float v) { v = dpp_add<0xB1, 0xF>(v); v = dpp_add<0x4E, 0xF>(v); v = dpp_add<0x141, 0xF>(v); v = dpp_add<0x140, 0xF>(v); return v; }
__device__ __forceinline__ float half_sum(float v, int hi) {
    v = dpp_add<0x142, 0xA>(row_sums(v)); const int a = __builtin_bit_cast(int, v);
    const float lo_ = __builtin_bit_cast(float, __builtin_amdgcn_readlane(a, 31)), hi_ = __builtin_bit_cast(float, __builtin_amdgcn_readlane(a, 63));
    return hi ? hi_ : lo_; }
__device__ __forceinline__ float wave_sum(float v) {
    v = dpp_add<0x143, 0xC>(dpp_add<0x142, 0xA>(row_sums(v)));
    return __builtin_bit_cast(float, __builtin_amdgcn_readlane(__builtin_bit_cast(int, v), 63));
}

#define XB_TMO      128
#define XB_XCNT(j)  (256  + 64 * (j))
#define XB_XSUB(j)  (1280 + 64 * (j))
#define XB_XGEN(j)  (2304 + 64 * (j))
#define XB_TOP      3328
#define XB_TOPGEN   3392
#define XCD_BAR_WORDS 3456
#define XB_SPIN_CAP (1u << 18)
__device__ __forceinline__ unsigned xb_ld(unsigned* p)              { return __hip_atomic_load(p, __ATOMIC_RELAXED, __HIP_MEMORY_SCOPE_AGENT); }
__device__ __forceinline__ unsigned xb_add(unsigned* p, unsigned v) { return __hip_atomic_fetch_add(p, v, __ATOMIC_RELAXED, __HIP_MEMORY_SCOPE_AGENT); }
__device__ __forceinline__ unsigned xb_xcc_id() { return (unsigned)__builtin_amdgcn_s_getreg((3 << 11) | 20) & 0xFu; }
#define XB_SPIN(cond, bar) do { unsigned _sp = 0; while (cond) { __builtin_amdgcn_s_sleep(1); \
    if ((++_sp & 255u) == 0u) { if (xb_ld(&(bar)[XB_TMO])) break; if (_sp > XB_SPIN_CAP) { atomicAdd(&(bar)[XB_TMO], 1u); break; } } } } while (0)
struct XcdBarrier { unsigned* bar; unsigned x; volatile LAS unsigned* st; };
__device__ __forceinline__ XcdBarrier xcd_barrier_post(unsigned* bar, volatile LAS unsigned* st) {
    XcdBarrier b; b.bar = bar; b.x = xb_xcc_id(); b.st = st;
    if (threadIdx.x == 0) (void)xb_add(&bar[XB_XCNT(b.x)], 1u);
    return b;
}
__device__ __forceinline__ void xcd_barrier_complete(unsigned* bar, unsigned x, unsigned& nloc, unsigned& nx) {
    const unsigned G = gridDim.x * gridDim.y * gridDim.z;
    unsigned sum, cnt, mine, sp = 0u;
    for (;;) {
        sum = 0u; cnt = 0u; mine = 0u;
#pragma unroll
        for (unsigned j = 0; j < 16; ++j) { const unsigned c = xb_ld(&bar[XB_XCNT(j)]); sum += c; cnt += (c > 0u) ? 1u : 0u; mine = (j == x) ? c : mine; }
        if (sum == G) break;
        __builtin_amdgcn_s_sleep(1);
        if ((++sp & 255u) == 0u) { if (xb_ld(&bar[XB_TMO])) break; if (sp > XB_SPIN_CAP) { atomicAdd(&bar[XB_TMO], 1u); break; } }
    }
    nloc = mine > 0u ? mine : 1u; nx = cnt > 0u ? cnt : 1u;
}
__device__ __forceinline__ void xcd_barrier(const XcdBarrier& b) {
    asm volatile("s_waitcnt vmcnt(0)" ::: "memory");
    __syncthreads();
    if (threadIdx.x == 0) {
        unsigned* bar = b.bar;
        __builtin_amdgcn_s_waitcnt(0);
        unsigned nloc = b.st[0], nx = b.st[1];
        if (nloc == 0u) { xcd_barrier_complete(bar, b.x, nloc, nx); b.st[0] = nloc; b.st[1] = nx; }
        const unsigned old = xb_add(&bar[XB_XSUB(b.x)], 1u);
        const unsigned gen = old / nloc;
        if (old + 1u == (gen + 1u) * nloc) {
            __builtin_amdgcn_fence(__ATOMIC_RELEASE, "agent");
            asm volatile("s_waitcnt vmcnt(0)" ::: "memory");
            const unsigned og = xb_add(&bar[XB_TOP], 1u);
            const unsigned tg = og / nx;
            if (og + 1u == (tg + 1u) * nx) xb_add(&bar[XB_TOPGEN], 1u);
            else XB_SPIN(xb_ld(&bar[XB_TOPGEN]) == tg, bar);
            __builtin_amdgcn_fence(__ATOMIC_ACQUIRE, "agent");
            xb_add(&bar[XB_XGEN(b.x)], 1u);
            asm volatile("s_waitcnt vmcnt(0)" ::: "memory");
        } else {
            XB_SPIN(xb_ld(&bar[XB_XGEN(b.x)]) == gen, bar);
            __builtin_amdgcn_fence(__ATOMIC_ACQUIRE, "agent");
            asm volatile("s_waitcnt vmcnt(0)" ::: "memory");
        }
    }
    __syncthreads();
}

namespace pg8 {
constexpr int BM = 256, BK = 64, HALF = 128, HTB = HALF * BK * 2, STAGE_BYTES = 8 * HTB, NXCD = 8, WGM = 8;
__host__ __device__ __forceinline__ int lds_byte(int r, int c) { const int st = (r >> 4) * 2 + (c >> 5), rr = r & 15, cc = c & 31, ob = rr * 64 + cc * 2; return st * 1024 + (ob ^ (((ob >> 9) & 1) << 5)); }
__host__ __device__ __forceinline__ void stage_rc(int b, int& R, int& C) { const int st = b / 1024, sb = b % 1024, swz = sb ^ (((sb >> 9) & 1) << 5); R = (st >> 1) * 16 + swz / 64; C = (st & 1) * 32 + (swz % 64) / 2; }
__host__ __device__ __forceinline__ int perm32(int rho) { const int n = rho >> 4, i = rho & 15; return 8 * (i >> 2) + 4 * n + (i & 3); }
struct Unit { int pm, pn, q, cnt; };
typedef f32x4 Acc[2][2][4][2];
typedef int v4i_t __attribute__((ext_vector_type(4)));
__device__ __forceinline__ bool dense_next(int nM, int nN, int G, int c, int i, Unit& u) {
    const int nwg = nM * nN; const long L = (long)i * G + c; if (L >= nwg) return false;
    int wgid = (int)L; { const int q = nwg / NXCD, r = nwg % NXCD, xcd = wgid % NXCD, off = wgid / NXCD; wgid = (xcd < r ? xcd * (q + 1) : r * (q + 1) + (xcd - r) * q) + off; }
    const int nig = WGM * nN, gid = wgid / nig, fm = gid * WGM, gsz = (nM - fm) < WGM ? (nM - fm) : WGM;
    u.pm = fm + ((wgid % nig) % gsz); u.pn = (wgid % nig) / gsz; u.q = 0; u.cnt = 256; return true;
}
__device__ __forceinline__ void lane_rc(int& R, int& C) { int t = threadIdx.x; asm volatile("" : "+v"(t)); stage_rc(t * 16, R, C); }
template <class P>
__device__ __forceinline__ void gemm_phase(LAS unsigned char* lds, const P& p) {
    int tid = threadIdx.x; asm volatile("" : "+v"(tid));
    const int wid = __builtin_amdgcn_readfirstlane(tid >> 6), lane = tid & 63, wr = wid >> 2, wc = wid & 3, fr = lane & 15, fq = lane >> 4;
    constexpr int nt = P::NT; constexpr int NA = P::GATHER ? 4 : 1;
    unsigned voffB;
    constexpr bool F8 = P::FP8;
    { int R0, C0; stage_rc(tid * 16, R0, C0); const int Rb = P::PERM ? ((R0 & ~31) + perm32(R0 & 31)) : R0; voffB = (unsigned)(Rb * P::RBB + C0 * 2); }
    constexpr size_t qstepB = (size_t)64 * P::RBB, qstepA = (size_t)64 * P::RBA;
    const unsigned ldsw = (unsigned)wid * 1024u;
    const int aoff = lds_byte(wr * 64 + fr, F8 ? fq * 16 : fq * 8), boff = lds_byte(wc * 32 + fr, F8 ? fq * 16 : fq * 8);
    constexpr int KOFF = F8 ? 16 : 1024;
#define PG8_SA(b, h) (((b) * 2 + (h)) * HTB)
#define PG8_SB(b, h) ((4 + (b) * 2 + (h)) * HTB)
#define PG8_GLDS(gp, bufoff, i) __builtin_amdgcn_global_load_lds((const unsigned*)(gp), (LAS unsigned*)(lds + (bufoff) + ldsw + (i) * 8192), 16, 0, 0)
#define PG8_STAGE_B(bufoff, gbase, h) do { _Pragma("unroll") for (int _i = 0; _i < 2; ++_i) PG8_GLDS((const char*)(gbase) + (size_t)(2 * (h) + _i) * qstepB + voffB, bufoff, _i); } while (0)
#define PG8_STAGE_A(bufoff, gbase, h, ao) do { _Pragma("unroll") for (int _i = 0; _i < 2; ++_i) { \
        if constexpr (P::GATHER) PG8_GLDS((const char*)(gbase) + (ao)[2 * (h) + _i], bufoff, _i); else PG8_GLDS((const char*)(gbase) + (size_t)(2 * (h) + _i) * qstepA + (ao)[0], bufoff, _i); } } while (0)
#define PG8_LDA(dst, b, h) do { _Pragma("unroll") for (int m = 0; m < 4; ++m) _Pragma("unroll") for (int k = 0; k < 2; ++k) dst[m][k] = *(const LAS bf16x8*)(lds + PG8_SA(b, h) + aoff + m * 2048 + k * KOFF); } while (0)
#define PG8_LDB(dst, b, h) do { _Pragma("unroll") for (int n = 0; n < 2; ++n) _Pragma("unroll") for (int k = 0; k < 2; ++k) dst[n][k] = *(const LAS bf16x8*)(lds + PG8_SB(b, h) + boff + n * 2048 + k * KOFF); } while (0)
#define PG8_CAT(X) __builtin_shufflevector(__builtin_bit_cast(v4i_t, (X)[0]), __builtin_bit_cast(v4i_t, (X)[1]), 0, 1, 2, 3, 4, 5, 6, 7)
#define PG8_MMA(ai, bj, At, Bt) do { __builtin_amdgcn_s_setprio(1); \
        if constexpr (F8) { _Pragma("unroll") for (int m = 0; m < 4; ++m) _Pragma("unroll") for (int n = 0; n < 2; ++n) \
            asm volatile("v_mfma_scale_f32_16x16x128_f8f6f4 %0, %1, %2, %0, %3, %3 op_sel_hi:[0,0,0]" : "+v"(acc[ai][bj][m][n]) : "v"(PG8_CAT(Bt[n])), "v"(PG8_CAT(At[m])), "v"(mxsc)); } \
        else { _Pragma("unroll") for (int m = 0; m < 4; ++m) _Pragma("unroll") for (int n = 0; n < 2; ++n) _Pragma("unroll") for (int k = 0; k < 2; ++k) \
            acc[ai][bj][m][n] = __builtin_amdgcn_mfma_f32_16x16x32_bf16(Bt[n][k], At[m][k], acc[ai][bj][m][n], 0, 0, 0); } \
        __builtin_amdgcn_s_setprio(0); } while (0)
#define PG8_WAIT_V(n) asm volatile("s_waitcnt vmcnt(" #n ")" ::: "memory")
#define PG8_WAIT_L(n) asm volatile("s_waitcnt lgkmcnt(" #n ")" ::: "memory")
#define PG8_BAR __builtin_amdgcn_s_barrier()
#define PG8_SCHED __builtin_amdgcn_sched_barrier(0)
    Unit cur, nxt; int ui = 0;
    if (!p.next(0, cur)) return;
    Acc acc;
#pragma unroll
    for (int a = 0; a < 2; ++a)
#pragma unroll
        for (int b = 0; b < 2; ++b)
#pragma unroll
            for (int m = 0; m < 4; ++m)
#pragma unroll
                for (int n = 0; n < 2; ++n) acc[a][b][m][n] = (f32x4){0.f, 0.f, 0.f, 0.f};
    bf16x8 At[4][2], B0[2][2], B1[2][2];
    const int mxsc = 0x7F7F7F7F;
    unsigned aC[NA], aN[NA];
    { int R0, C0; lane_rc(R0, C0); p.a_off(cur, R0, C0, aC); }
    {
        const char* a0 = p.a_base(cur, 0); const char* b0 = p.b_base(cur, 0); const char* a1 = p.a_base(cur, 1); const char* b1 = p.b_base(cur, 1);
        PG8_STAGE_B(PG8_SB(0, 0), b0, 0); PG8_STAGE_B(PG8_SB(0, 1), b0, 1); PG8_STAGE_A(PG8_SA(0, 0), a0, 0, aC); PG8_STAGE_A(PG8_SA(0, 1), a0, 1, aC);
        if (wr == 1) PG8_BAR;
        PG8_WAIT_V(2); PG8_BAR;
        PG8_STAGE_B(PG8_SB(1, 0), b1, 0); PG8_STAGE_A(PG8_SA(1, 0), a1, 0, aC); PG8_STAGE_B(PG8_SB(1, 1), b1, 1);
        PG8_WAIT_V(6); PG8_BAR;
    }
    for (;;) {
        const bool has_next = p.next(ui + 1, nxt);
        if (has_next) { int R0, C0; lane_rc(R0, C0); p.a_off(nxt, R0, C0, aN); }
        else { nxt = cur;
#pragma unroll
            for (int i = 0; i < NA; ++i) aN[i] = aC[i]; }
#pragma unroll 1
        for (int t = 0; t < nt; t += 2) {
            const bool last = (t == nt - 2);
            if constexpr (P::HAS_MID) p.mid(acc, cur, t, wr, wc, fr, fq);
            const char* a1 = p.a_base(cur, t + 1);
            const char* a2 = last ? p.a_base(nxt, 0) : p.a_base(cur, t + 2); const char* b2 = last ? p.b_base(nxt, 0) : p.b_base(cur, t + 2);
            const char* a3 = last ? p.a_base(nxt, 1) : p.a_base(cur, t + 3); const char* b3 = last ? p.b_base(nxt, 1) : p.b_base(cur, t + 3);
            PG8_LDB(B0, 0, 0); PG8_LDB(B1, 0, 1); PG8_SCHED; PG8_LDA(At, 0, 0); PG8_STAGE_A(PG8_SA(1, 1), a1, 1, aC);
            if (last) {
#pragma unroll
                for (int i = 0; i < NA; ++i) aC[i] = aN[i]; }
            PG8_WAIT_V(8); PG8_WAIT_L(0); PG8_BAR; PG8_MMA(0, 0, At, B0); PG8_MMA(0, 1, At, B1); PG8_BAR; PG8_SCHED;
            PG8_LDA(At, 0, 1); PG8_STAGE_B(PG8_SB(0, 0), b2, 0); PG8_STAGE_B(PG8_SB(0, 1), b2, 1); PG8_STAGE_A(PG8_SA(0, 0), a2, 0, aC);
            PG8_WAIT_V(8); PG8_WAIT_L(0); PG8_BAR; PG8_MMA(1, 0, At, B0); PG8_MMA(1, 1, At, B1); PG8_BAR; PG8_SCHED;
            PG8_LDB(B0, 1, 0); PG8_LDB(B1, 1, 1); PG8_SCHED; PG8_LDA(At, 1, 0); PG8_STAGE_A(PG8_SA(0, 1), a2, 1, aC);
            PG8_WAIT_V(8); PG8_WAIT_L(0); PG8_BAR; PG8_MMA(0, 0, At, B0); PG8_MMA(0, 1, At, B1); PG8_BAR; PG8_SCHED;
            PG8_LDA(At, 1, 1); PG8_STAGE_B(PG8_SB(1, 0), b3, 0); PG8_STAGE_B(PG8_SB(1, 1), b3, 1); PG8_STAGE_A(PG8_SA(1, 0), a3, 0, aC);
            PG8_WAIT_V(8); PG8_WAIT_L(0); PG8_BAR; PG8_MMA(1, 0, At, B0); PG8_MMA(1, 1, At, B1); PG8_BAR; PG8_SCHED;
        }
        if (wr == 0) PG8_BAR;
        if constexpr (F8) asm volatile("s_nop 15\n\ts_nop 15" ::: "memory");
        p.epi(acc, cur, wr, wc, fr, fq);
        if (!has_next) break;
#pragma unroll
        for (int a = 0; a < 2; ++a)
#pragma unroll
            for (int b = 0; b < 2; ++b)
#pragma unroll
                for (int m = 0; m < 4; ++m)
#pragma unroll
                    for (int n = 0; n < 2; ++n) acc[a][b][m][n] = (f32x4){0.f, 0.f, 0.f, 0.f};
        cur = nxt; ++ui;
        if (wr == 1) PG8_BAR;
    }
    PG8_WAIT_V(0);
    PG8_BAR;
#undef PG8_SA
#undef PG8_SB
#undef PG8_GLDS
#undef PG8_STAGE_A
#undef PG8_STAGE_B
#undef PG8_LDA
#undef PG8_LDB
#undef PG8_MMA
#undef PG8_CAT
#undef PG8_WAIT_V
#undef PG8_WAIT_L
#undef PG8_BAR
#undef PG8_SCHED
}
}
using pg8::Unit; using pg8::Acc;

struct Args { const float* in[21]; float* out; unsigned char* ws; int ph_lo, ph_hi, dry, pad; };

struct DenseBase {
    const char* A; const char* B; int nM, nN, G, c;
    __device__ __forceinline__ bool next(int i, Unit& u) const { return pg8::dense_next(nM, nN, G, c, i, u); }
};
template <bool SIG, bool F8_ = false> struct PInProj : DenseBase {
    static constexpr int NT = F8_ ? 8 : 16, LDA = 1024, LDB = 1024, RBA = F8_ ? 1024 : 2048, RBB = F8_ ? 1024 : 2048; static constexpr bool PERM = true, HAS_MID = false, GATHER = false, FP8 = F8_;
    bf16* O; int ldc;
    static __device__ __forceinline__ float sg(float z) { z = fmaxf(z, -30.f); return __builtin_amdgcn_rcpf(1.f + __builtin_amdgcn_exp2f(-z * LOG2E)); }
    __device__ __forceinline__ void a_off(const Unit& u, int R0, int C0, unsigned (&off)[1]) const { off[0] = (unsigned)((u.pm * 256 + R0) * RBA + C0 * 2); }
    __device__ __forceinline__ const char* a_base(const Unit&, int t) const { return A + (size_t)t * 128; }
    __device__ __forceinline__ const char* b_base(const Unit& u, int t) const { return B + (size_t)u.pn * 256 * RBB + (size_t)t * 128; }
    __device__ __forceinline__ void mid(Acc&, const Unit&, int, int, int, int, int) const {}
    __device__ __forceinline__ void epi(const Acc& acc, const Unit& u, int wr, int wc, int fr, int fq) const {
        const int row0 = u.pm * 256 + wr * 64 + fr, col0 = u.pn * 256 + wc * 32 + 8 * fq;
#pragma unroll
        for (int ai = 0; ai < 2; ++ai)
#pragma unroll
            for (int m = 0; m < 4; ++m) { bf16* rowp = O + (size_t)(row0 + ai * 128 + m * 16) * ldc + col0;
#pragma unroll
                for (int bj = 0; bj < 2; ++bj) { f32x4 v0 = acc[ai][bj][m][0], v1 = acc[ai][bj][m][1];
                    constexpr float SC = F8_ ? (1.f / 32.f) : 1.f;
                    if (SIG) {
                        unsigned q[8];
#pragma unroll
                        for (int j = 0; j < 4; ++j) { q[j] = (unsigned)fmaxf(__builtin_rintf(sg(v0[j] * SC) * 255.f), 1.f); q[4 + j] = (unsigned)fmaxf(__builtin_rintf(sg(v1[j] * SC) * 255.f), 1.f); }
                        v2u w8; w8.x = q[0] | (q[1] << 8) | (q[2] << 16) | (q[3] << 24); w8.y = q[4] | (q[5] << 8) | (q[6] << 16) | (q[7] << 24);
                        *(v2u*)((unsigned char*)O + (size_t)(row0 + ai * 128 + m * 16) * ldc + col0 + bj * 128) = w8;
                        asm volatile("" ::: "memory");
                        continue; }
                    else if (F8_) { v0 *= SC; v1 *= SC; }
                    asm volatile("" ::: "memory");
                    v4u w; w.x = cvt_pk_bf16(v0[0], v0[1]); w.y = cvt_pk_bf16(v0[2], v0[3]); w.z = cvt_pk_bf16(v1[0], v1[1]); w.w = cvt_pk_bf16(v1[2], v1[3]);
                    *(v4u*)(rowp + bj * 128) = w; } }
    }
};
struct PMerge : DenseBase {
    static constexpr int NT = 24, LDA = 1536, LDB = 1536, RBA = 3072, RBB = 3072; static constexpr bool PERM = true, HAS_MID = true, GATHER = false, FP8 = false;
    const bf16* PG; bf16* O;
    __device__ __forceinline__ void a_off(const Unit& u, int R0, int C0, unsigned (&off)[1]) const { off[0] = (unsigned)((u.pm * 256 + R0) * LDA + C0) * 2u; }
    __device__ __forceinline__ const char* a_base(const Unit&, int t) const { return A + (size_t)t * 128; }
    __device__ __forceinline__ const char* b_base(const Unit& u, int t) const { return B + (size_t)u.pn * 256 * LDB * 2 + (size_t)t * 128; }
    static __device__ __forceinline__ float ub(unsigned w, int k) { return (float)((w >> (8 * k)) & 0xffu); }
    template <int MODE> __device__ __forceinline__ void scale(Acc& acc, const Unit& u, int b, int wr, int wc, int fr, int fq) const {
        unsigned loff = (unsigned)(fr * 3072 + 8 * fq), looff = (unsigned)(fr * 1024 + 8 * fq) * 2u;
        asm volatile("" : "+v"(loff), "+v"(looff));
        const char* zbase = (const char*)PG + ((size_t)(u.pm * 256 + wr * 64) * 3072 + (size_t)b * 1024 + u.pn * 256 + wc * 32);
        char* obase = (char*)O + ((size_t)(u.pm * 256 + wr * 64) * 1024 + u.pn * 256 + wc * 32) * 2;
#pragma unroll
        for (int ai = 0; ai < 2; ++ai) {
            v2u zb[4][2], zn[4][2];
#pragma unroll
            for (int m = 0; m < 4; ++m)
#pragma unroll
                for (int bj = 0; bj < 2; ++bj) { const char* zr = zbase + (size_t)(ai * 128 + m * 16) * 3072;
                    zb[m][bj] = *(const v2u*)(zr + loff + bj * 128); if (MODE == 0) zn[m][bj] = *(const v2u*)(zr + 1024 + loff + bj * 128); }
#pragma unroll
            for (int m = 0; m < 4; ++m)
#pragma unroll
                for (int bj = 0; bj < 2; ++bj) { float f[8];
#pragma unroll
                    for (int j = 0; j < 8; ++j) { const float gb = ub(zb[m][bj][j >> 2], j & 3);
                        f[j] = MODE == 0 ? gb * __builtin_amdgcn_rcpf(ub(zn[m][bj][j >> 2], j & 3)) : gb * (1.f / 255.f); }
                    f32x4 v0 = acc[ai][bj][m][0], v1 = acc[ai][bj][m][1];
                    v0[0] *= f[0]; v0[1] *= f[1]; v0[2] *= f[2]; v0[3] *= f[3]; v1[0] *= f[4]; v1[1] *= f[5]; v1[2] *= f[6]; v1[3] *= f[7];
                    if (MODE == 0) { acc[ai][bj][m][0] = v0; acc[ai][bj][m][1] = v1; }
                    else { v4u w; w.x = cvt_pk_bf16(v0[0], v0[1]); w.y = cvt_pk_bf16(v0[2], v0[3]); w.z = cvt_pk_bf16(v1[0], v1[1]); w.w = cvt_pk_bf16(v1[2], v1[3]);
                        *(v4u*)(obase + (size_t)(ai * 128 + m * 16) * 1024 * 2 + looff + bj * 256) = w; } }
            asm volatile("" ::: "memory"); }
    }
    __device__ __forceinline__ void mid(Acc& acc, const Unit& u, int t, int wr, int wc, int fr, int fq) const {
        if (t == 8 || t == 16) scale<0>(acc, u, t == 8 ? 0 : 1, wr, wc, fr, fq);
    }
    __device__ __forceinline__ void epi(Acc& acc, const Unit& u, int wr, int wc, int fr, int fq) const { scale<1>(acc, u, 2, wr, wc, fr, fq); }
};
struct POut : DenseBase {
    static constexpr int NT = 16, LDA = 1024, LDB = 1024, RBA = 2048, RBB = 2048; static constexpr bool PERM = false, HAS_MID = false, GATHER = false, FP8 = false;
    const float* base; float* X;
    __device__ __forceinline__ void a_off(const Unit& u, int R0, int C0, unsigned (&off)[1]) const { off[0] = (unsigned)((u.pm * 256 + R0) * LDA + C0) * 2u; }
    __device__ __forceinline__ const char* a_base(const Unit&, int t) const { return A + (size_t)t * 128; }
    __device__ __forceinline__ const char* b_base(const Unit& u, int t) const { return B + (size_t)u.pn * 256 * LDB * 2 + (size_t)t * 128; }
    __device__ __forceinline__ void mid(Acc&, const Unit&, int, int, int, int, int) const {}
    __device__ __forceinline__ void epi(const Acc& acc, const Unit& u, int wr, int wc, int fr, int fq) const {
        const int row0 = u.pm * 256 + wr * 64 + fr, col0 = u.pn * 256 + wc * 32 + 4 * fq;
#pragma unroll
        for (int ai = 0; ai < 2; ++ai) {
            f32x4 bv[4][2][2];
#pragma unroll
            for (int m = 0; m < 4; ++m) { const size_t o = (size_t)(row0 + ai * 128 + m * 16) * 1024 + col0;
#pragma unroll
                for (int bj = 0; bj < 2; ++bj)
#pragma unroll
                    for (int n = 0; n < 2; ++n) bv[m][bj][n] = *(const f32x4*)(base + o + bj * 128 + n * 16); }
#pragma unroll
            for (int m = 0; m < 4; ++m) { const size_t o = (size_t)(row0 + ai * 128 + m * 16) * 1024 + col0;
#pragma unroll
                for (int bj = 0; bj < 2; ++bj)
#pragma unroll
                    for (int n = 0; n < 2; ++n) *(f32x4*)(X + o + bj * 128 + n * 16) = bv[m][bj][n] + acc[ai][bj][m][n]; }
            asm volatile("" ::: "memory"); }
    }
};
struct MoeBase {
    const volatile LAS int* tp; const int* list; const float* tw; int ncol, G, c;
    __device__ __forceinline__ bool next(int i, Unit& u) const {
        const int ntr = tp[24]; const long L = (long)i * G + c; if (L >= (long)ntr * ncol) return false;
        const int rt = (int)(L / ncol); u.pn = (int)(L % ncol); u.pm = rt;
        int q = 0;
#pragma unroll 1
        for (int j = 1; j < 24; ++j) if (tp[j] <= rt) q = j;
        u.q = q; const int lt = rt - tp[q]; const int cq = tp[32 + q]; u.cnt = (cq - lt * 256) < 256 ? (cq - lt * 256) : 256; return true;
    }
    static __device__ __forceinline__ void experts(int q, int& e1, int& e2) { const int g = q / 6, pr = q % 6; const int lo = pr < 3 ? 0 : (pr < 5 ? 1 : 2); const int hi = pr < 3 ? pr + 1 : (pr < 5 ? pr - 1 : 3); e1 = g * 4 + lo; e2 = g * 4 + hi; }
    __device__ __forceinline__ int token_of(const Unit& u, int r) const { const int lt = u.pm - tp[u.q]; return list[u.q * LISTCAP + lt * 256 + r]; }
};
struct PGateUp : MoeBase {
    static constexpr int NT = 8, RBA = 1024, RBB = 1024; static constexpr bool PERM = true, HAS_MID = false, GATHER = true, FP8 = true;
    const char* A; const char* W; unsigned char* hid;
    __device__ __forceinline__ void a_off(const Unit& u, int R0, int C0, unsigned (&off)[4]) const {
#pragma unroll
        for (int j = 0; j < 4; ++j) { const int r = j * 64 + R0; const int tok = r < u.cnt ? token_of(u, r) : 0; off[j] = (unsigned)(tok * 1024 + C0 * 2); } }
    __device__ __forceinline__ const char* a_base(const Unit&, int t) const { return A + (size_t)t * 128; }
    __device__ __forceinline__ const char* b_base(const Unit& u, int t) const { int e1, e2; experts(u.q, e1, e2); const int e = (u.pn >> 2) ? e2 : e1;
        return W + ((size_t)e * 1024 + (size_t)(u.pn & 3) * 256) * 1024 + (size_t)t * 128; }
    __device__ __forceinline__ void mid(Acc&, const Unit&, int, int, int, int, int) const {}
    __device__ __forceinline__ void epi(const Acc& acc, const Unit& u, int wr, int wc, int fr, int fq) const {
        const int s = u.pn >> 2, hc0 = s * 512 + (u.pn & 3) * 128 + wc * 16 + 4 * fq;
        float wv[2][4];
        { int tk[2][4];
#pragma unroll
          for (int ai = 0; ai < 2; ++ai)
#pragma unroll
            for (int m = 0; m < 4; ++m) { const int r = ai * 128 + wr * 64 + m * 16 + fr; tk[ai][m] = r < u.cnt ? token_of(u, r) : -1; }
#pragma unroll
          for (int ai = 0; ai < 2; ++ai)
#pragma unroll
            for (int m = 0; m < 4; ++m) wv[ai][m] = tk[ai][m] >= 0 ? tw[2 * tk[ai][m] + s] * 16.f : 0.f; }
#pragma unroll
        for (int ai = 0; ai < 2; ++ai)
#pragma unroll
            for (int m = 0; m < 4; ++m) { const int r = ai * 128 + wr * 64 + m * 16 + fr;
                const float w = wv[ai][m];
                unsigned char* rowp = hid + (size_t)(u.pm * 256 + r) * 1024 + hc0;
#pragma unroll
                for (int bj = 0; bj < 2; ++bj) { const f32x4 g = acc[ai][bj][m][0] * (1.f / 32.f), up = acc[ai][bj][m][1] * (1.f / 32.f); float o[4];
#pragma unroll
                    for (int j = 0; j < 4; ++j) { const float sg = __builtin_amdgcn_rcpf(1.f + __builtin_amdgcn_exp2f(-fminf(fmaxf(g[j], -60.f), 60.f) * LOG2E)); o[j] = g[j] * sg * up[j] * w; }
                    *(unsigned*)(rowp + bj * 64) = pk4_fp8(o[0], o[1], o[2], o[3]); } }
    }
};
struct PDown : MoeBase {
    static constexpr int NT = 8, RBA = 1024, RBB = 512; static constexpr bool PERM = false, HAS_MID = false, GATHER = false, FP8 = true;
    const char* A; const char* W; float* X; int dry;
    __device__ __forceinline__ void a_off(const Unit& u, int R0, int C0, unsigned (&off)[1]) const { off[0] = (unsigned)((u.pm * 256 + R0) * RBA + C0 * 2); }
    __device__ __forceinline__ const char* a_base(const Unit&, int t) const { return A + (size_t)t * 128; }
    __device__ __forceinline__ const char* b_base(const Unit& u, int t) const { int e1, e2; experts(u.q, e1, e2); const int e = t >= 4 ? e2 : e1;
        return W + ((size_t)e * 1024 + (size_t)u.pn * 256) * 512 + (size_t)(t & 3) * 128; }
    __device__ __forceinline__ void mid(Acc&, const Unit&, int, int, int, int, int) const {}
    __device__ __forceinline__ void epi(const Acc& acc, const Unit& u, int wr, int wc, int fr, int fq) const {
        const int col0 = u.pn * 256 + wc * 32 + 4 * fq;
#pragma unroll
        for (int ai = 0; ai < 2; ++ai) {
            int tok[4];
#pragma unroll
            for (int m = 0; m < 4; ++m) { const int r = ai * 128 + wr * 64 + m * 16 + fr; tok[m] = (r < u.cnt && !dry) ? token_of(u, r) : -1; }
            f32x4 bv[4][2][2];
#pragma unroll
            for (int m = 0; m < 4; ++m) if (tok[m] >= 0) { const float* xr = X + (size_t)tok[m] * 1024 + col0;
#pragma unroll
                for (int bj = 0; bj < 2; ++bj)
#pragma unroll
                    for (int n = 0; n < 2; ++n) bv[m][bj][n] = *(const f32x4*)(xr + bj * 128 + n * 16); }
#pragma unroll
            for (int m = 0; m < 4; ++m) if (tok[m] >= 0) { float* xr = X + (size_t)tok[m] * 1024 + col0;
#pragma unroll
                for (int bj = 0; bj < 2; ++bj)
#pragma unroll
                    for (int n = 0; n < 2; ++n) *(f32x4*)(xr + bj * 128 + n * 16) = bv[m][bj][n] + acc[ai][bj][m][n] * (1.f / 256.f); }
            asm volatile("" ::: "memory"); }
    }
};

struct Frame {
    LAS unsigned char* lds; volatile LAS unsigned* MISC; unsigned* ctl;
    int tid, lane, wave, vcu, G;
};
template <int GU> __device__ __forceinline__ void transpose_item(const float* W, int K, int N, bf16* WT, int ldk, int dst_row0, int dst_col0, LAS float* scr, int item, int lane, float sc = 1.f) {
    const int nblk = N / 32, kb = item / nblk, nb = item % nblk, k0 = 64 * kb, n0 = 32 * nb;
    { float tmp_[32];
#pragma unroll
      for (int i = 0; i < 32; ++i) tmp_[i] = W[(size_t)(k0 + 2 * i + (lane >> 5)) * N + n0 + (lane & 31)];
#pragma unroll
      for (int i = 0; i < 32; ++i) scr[(2 * i + (lane >> 5)) * 33 + (lane & 31)] = tmp_[i] * sc; }
    LDS_WAIT(); asm volatile("" ::: "memory");
    const int c = lane & 7;
#pragma unroll
    for (int j = 0; j < 4; ++j) { const int n = (lane >> 3) + 8 * j; const LAS float* s = scr + (8 * c) * 33 + n;
        v4u o; o.x = pk2(s[0 * 33], s[1 * 33]); o.y = pk2(s[2 * 33], s[3 * 33]); o.z = pk2(s[4 * 33], s[5 * 33]); o.w = pk2(s[6 * 33], s[7 * 33]);
        int drow;
        if (GU == 0) drow = dst_row0 + n0 + n;
        else { const int jj = n0 + n; drow = dst_row0 + 8 * (jj >> 2) + (jj & 3); }
        *(v4u*)(WT + (size_t)drow * ldk + dst_col0 + k0 + 8 * c) = o; }
    LDS_WAIT(); asm volatile("" ::: "memory");
}
template <int GU> __device__ __forceinline__ void transpose_item8(const float* W, int K, int N, unsigned char* WT, int ldk, int dst_row0, int dst_col0, float sc, LAS float* scr, int item, int lane) {
    const int nblk = N / 32, kb = item / nblk, nb = item % nblk, k0 = 64 * kb, n0 = 32 * nb;
    { float tmp_[32];
#pragma unroll
      for (int i = 0; i < 32; ++i) tmp_[i] = W[(size_t)(k0 + 2 * i + (lane >> 5)) * N + n0 + (lane & 31)];
#pragma unroll
      for (int i = 0; i < 32; ++i) scr[(2 * i + (lane >> 5)) * 33 + (lane & 31)] = tmp_[i]; }
    LDS_WAIT(); asm volatile("" ::: "memory");
    const int n = lane >> 1, kh = (lane & 1) * 32; const LAS float* sp = scr + kh * 33 + n;
    v4u o0, o1;
#pragma unroll
    for (int j = 0; j < 4; ++j) { o0[j] = pk4_fp8(sp[(4 * j) * 33] * sc, sp[(4 * j + 1) * 33] * sc, sp[(4 * j + 2) * 33] * sc, sp[(4 * j + 3) * 33] * sc);
        o1[j] = pk4_fp8(sp[(16 + 4 * j) * 33] * sc, sp[(16 + 4 * j + 1) * 33] * sc, sp[(16 + 4 * j + 2) * 33] * sc, sp[(16 + 4 * j + 3) * 33] * sc); }
    int drow;
    if (GU == 0) drow = dst_row0 + n0 + n; else { const int jj = n0 + n; drow = dst_row0 + 8 * (jj >> 2) + (jj & 3); }
    unsigned char* dp = WT + (size_t)drow * ldk + dst_col0 + k0 + kh;
    *(v4u*)dp = o0; *(v4u*)(dp + 16) = o1;
    LDS_WAIT(); asm volatile("" ::: "memory");
}
__device__ __forceinline__ void convert_mixer_weights(Frame& F, const Args& a, int layer) {
    LAS float* scr = (LAS float*)(F.lds + F.wave * 16384);
    const int gw = F.vcu * NWAVES + F.wave, NGW = F.G * NWAVES;
    const float* w_in = a.in[3] + (size_t)layer * 1024 * D_IN; const float* w_br = a.in[10] + (size_t)layer * 3 * 512 * 1024; const float* w_out = a.in[11] + (size_t)layer * 1024 * 1024;
    bf16* WIN = (bf16*)(a.ws + WS_WIN); bf16* WBR = (bf16*)(a.ws + WS_WBR); bf16* WOUT = (bf16*)(a.ws + WS_WOUT);
    constexpr int I_IN = 16 * (D_IN / 32), I_BR = 8 * 32, I_OUT = 16 * 32;
    for (int it = gw; it < I_IN + 3 * I_BR + I_OUT; it += NGW) {
        int r = it;
        if (r < I_IN) { const int n0 = 32 * (r % (D_IN / 32));
            int d0; if (n0 < 1536) d0 = n0; else if (n0 < 6144) d0 = n0 - 1536 + 2560; else if (n0 < 7168) d0 = n0 - 6144 + 1536; else d0 = n0;
            if (n0 >= 7168) transpose_item8<0>(w_in, 1024, D_IN, (unsigned char*)WIN + (size_t)(N_AC + N_B) * 1024 * 2, 1024, -7168, 0, 32.f, scr, r, F.lane);
            else if (n0 >= 1536 && n0 < 6144) transpose_item8<0>(w_in, 1024, D_IN, (unsigned char*)WIN + (size_t)N_AC * 1024 * 2, 1024, -1536, 0, 32.f, scr, r, F.lane);
            else transpose_item<0>(w_in, 1024, D_IN, WIN, 1024, d0 - n0, 0, scr, r, F.lane, n0 < 512 ? da_QSC : 1.f);
            continue; }
        r -= I_IN;
        if (r < 3 * I_BR) { const int b = r / I_BR; transpose_item<0>(w_br + (size_t)b * 512 * 1024, 512, 1024, WBR, 1536, 0, b * 512, scr, r % I_BR, F.lane); continue; }
        r -= 3 * I_BR;
        transpose_item<0>(w_out, 1024, 1024, WOUT, 1024, 0, 0, scr, r, F.lane);
    }
}
__device__ __forceinline__ void convert_expert_weights(Frame& F, const Args& a, int layer) {
    LAS float* scr = (LAS float*)(F.lds + F.wave * 16384);
    const int gw = F.vcu * NWAVES + F.wave, NGW = F.G * NWAVES;
    const float* wg = a.in[17] + (size_t)layer * NEXP * 1024 * 512; const float* wu = a.in[18] + (size_t)layer * NEXP * 1024 * 512; const float* wd = a.in[19] + (size_t)layer * NEXP * 512 * 1024;
    bf16* WGU = (bf16*)(a.ws + WS_WGU); bf16* WD = (bf16*)(a.ws + WS_WD);
    constexpr int I_G = 16 * 16, I_D = 8 * 32;
    for (int it = gw; it < NEXP * (2 * I_G + I_D); it += NGW) {
        const int e = it / (2 * I_G + I_D); int r = it % (2 * I_G + I_D);
        if (r < I_G) { transpose_item8<1>(wg + (size_t)e * 1024 * 512, 1024, 512, (unsigned char*)WGU, 1024, e * 1024, 0, 32.f, scr, r, F.lane); continue; }
        r -= I_G;
        if (r < I_G) { transpose_item8<1>(wu + (size_t)e * 1024 * 512, 1024, 512, (unsigned char*)WGU, 1024, e * 1024 + 4, 0, 32.f, scr, r, F.lane); continue; }
        r -= I_G;
        transpose_item8<0>(wd + (size_t)e * 512 * 1024, 512, 1024, (unsigned char*)WD, 512, e * 1024, 0, 16.f, scr, r, F.lane);
    }
}
__device__ __forceinline__ int t5_bucket(int rel) {
    const int ret = rel > 0 ? 16 : 0; const int n = rel < 0 ? -rel : rel;
    if (n < 8) return ret + n;
    if (n >= 91) return ret + 15;
    unsigned long long p = (unsigned long long)n; p = p * p; p = p * p; p = p * p;
    const int lg = 63 - __builtin_clzll(p); int j = (lg - 24) >> 2; j = j > 7 ? 7 : j;
    return ret + 8 + j;
}
__device__ __forceinline__ void build_bias_tables(Frame& F, const Args& a) {
    const float* rb = a.in[1]; float* bta = (float*)(a.ws + WS_BTA); float* btb = (float*)(a.ws + WS_BTB);
    const int gt = F.vcu * 512 + F.tid, NT_ = F.G * 512;
    for (int i = gt; i < 4 * 8192; i += NT_) { const int h = i >> 13, idx = i & 8191; const int rel = idx - 4095; bta[i] = rb[t5_bucket(rel) * 28 + h]; }
    { const float* sw = a.in[8]; bf16* sgw = (bf16*)(a.ws + WS_SGW); for (int i = gt; i < 2 * 4 * 128 * 128; i += NT_) sgw[i] = (bf16)f2bf(sw[i]); }
    for (int i = gt; i < 3 * 8 * 192; i += NT_) { const int g = i / (8 * 192), hh = (i / 192) % 8, idx = i % 192; const int r = g == 0 ? 1 : (g == 1 ? 4 : 16);
        const int rel = idx - 96; btb[i] = (rel >= -64 && rel <= 64) ? rb[t5_bucket(rel * r) * 28 + 4 + g * 8 + hh] * 8.f : -1e30f; }
}
__device__ __forceinline__ void rms_row_to_bf16(const float* xrow, const float* g, bf16* orow, unsigned* orow8, int lane) {
    const f32x4* xr = (const f32x4*)xrow + lane; f32x4 v[4]; float s = 0.f;
#pragma unroll
    for (int j = 0; j < 4; ++j) { v[j] = xr[64 * j]; s += (v[j].x * v[j].x + v[j].y * v[j].y) + (v[j].z * v[j].z + v[j].w * v[j].w); }
    const float rstd = 1.f / sqrtf(wave_sum(s) * (1.f / DM) + EPS);
    unsigned long long* o8 = (unsigned long long*)orow + lane;
#pragma unroll
    for (int j = 0; j < 4; ++j) { const f32x4 gg = ((const f32x4*)g)[lane + 64 * j]; const f32x4 t = v[j] * rstd * gg;
        o8[64 * j] = (unsigned long long)pk2(t.x, t.y) | ((unsigned long long)pk2(t.z, t.w) << 32);
        orow8[lane + 64 * j] = pk4_fp8(t.x, t.y, t.z, t.w); }
}
__device__ __forceinline__ void phase_norm(Frame& F, const float* X, const float* g, bf16* H, unsigned char* H8) {
    const int gw = F.vcu * NWAVES + F.wave, NGW = F.G * NWAVES;
    const int lane = F.lane; f32x4 va[4], vb[4], vc[4];
    { const f32x4* x0 = (const f32x4*)(X + (size_t)gw * DM) + lane; const f32x4* x1 = (const f32x4*)(X + (size_t)(gw + NGW < T ? gw + NGW : gw) * DM) + lane;
#pragma unroll
      for (int j = 0; j < 4; ++j) { va[j] = x0[64 * j]; vb[j] = x1[64 * j]; } }
#pragma unroll 1
    for (int m = gw; m < T; m += NGW) {
        { const int m2 = m + 2 * NGW; const f32x4* x2 = (const f32x4*)(X + (size_t)(m2 < T ? m2 : m) * DM) + lane;
#pragma unroll
          for (int j = 0; j < 4; ++j) vc[j] = x2[64 * j]; }
        float s = 0.f;
#pragma unroll
        for (int j = 0; j < 4; ++j) s += (va[j].x * va[j].x + va[j].y * va[j].y) + (va[j].z * va[j].z + va[j].w * va[j].w);
        const float rstd = 1.f / sqrtf(wave_sum(s) * (1.f / DM) + EPS);
        unsigned long long* o8 = (unsigned long long*)(H + (size_t)m * DM) + lane; unsigned* q8 = (unsigned*)(H8 + (size_t)m * DM) + lane;
#pragma unroll
        for (int j = 0; j < 4; ++j) { const f32x4 gg = ((const f32x4*)g)[lane + 64 * j]; const f32x4 t = va[j] * rstd * gg;
            o8[64 * j] = (unsigned long long)pk2(t.x, t.y) | ((unsigned long long)pk2(t.z, t.w) << 32);
            q8[64 * j] = pk4_fp8(t.x, t.y, t.z, t.w); }
#pragma unroll
        for (int j = 0; j < 4; ++j) { va[j] = vb[j]; vb[j] = vc[j]; }
    }
}
__device__ __forceinline__ void phase_final_norm(Frame& F, float* X, const float* g) {
    const int gw = F.vcu * NWAVES + F.wave, NGW = F.G * NWAVES, lane = F.lane;
#pragma unroll 1
    for (int m0 = gw; m0 < T; m0 += 4 * NGW) {
        f32x4 v[4][4];
#pragma unroll
        for (int u = 0; u < 4; ++u) { const int m = m0 + u * NGW < T ? m0 + u * NGW : m0; const f32x4* xr = (const f32x4*)(X + (size_t)m * DM) + lane;
#pragma unroll
            for (int j = 0; j < 4; ++j) v[u][j] = xr[64 * j]; }
#pragma unroll
        for (int u = 0; u < 4; ++u) { const int m = m0 + u * NGW; if (m >= T) break;
            float s = 0.f;
#pragma unroll
            for (int j = 0; j < 4; ++j) s += (v[u][j].x * v[u][j].x + v[u][j].y * v[u][j].y) + (v[u][j].z * v[u][j].z + v[u][j].w * v[u][j].w);
            const float rstd = 1.f / sqrtf(wave_sum(s) * (1.f / DM) + EPS);
            f32x4* xw = (f32x4*)(X + (size_t)m * DM) + lane;
#pragma unroll
            for (int j = 0; j < 4; ++j) { const f32x4 gg = ((const f32x4*)g)[lane + 64 * j]; xw[64 * j] = v[u][j] * rstd * gg; } }
    }
}
__device__ __forceinline__ void phase_router(Frame& F, const Args& a, int layer, const float* X, bf16* H) {
    const int lane = F.lane, wid = F.wave, tid = F.tid;
    const float* g = a.in[12] + (size_t)layer * DM;
    const float* wrg = a.in[13] + (size_t)layer * DM * 4; const float* brg = a.in[14] + layer * 4;
    const float* wre = a.in[15] + (size_t)layer * 4 * DM * 4; const float* bre = a.in[16] + layer * 16;
    int* list = (int*)(a.ws + WS_LIST); float* tw = (float*)(a.ws + WS_TW); unsigned* cnt = F.ctl + CW_CNT + layer * 32;
    LAS f32x4* tab = (LAS f32x4*)F.lds;
    LAS int* tq = (LAS int*)(F.lds + 81920); LAS int* trank = tq + 128; LAS float* twl = (LAS float*)(trank + 128); LAS int* lcnt = (LAS int*)(twl + 256); LAS int* lbase = lcnt + 32; LAS float* lbias = (LAS float*)(lbase + 32);
    if (tid < 20) lbias[tid] = tid < 4 ? brg[tid] : bre[tid - 4];
    { f32x4 wv_[10]; float gv_[10];
#pragma unroll
      for (int k = 0; k < 10; ++k) { const int i = tid + 512 * k; const int q = i >> 10, jj = (i >> 6) & 15, l = i & 63; const int d = 4 * (l + 64 * (jj >> 2)) + (jj & 3);
        wv_[k] = q == 0 ? *(const f32x4*)(wrg + (size_t)d * 4) : *(const f32x4*)(wre + ((size_t)(q - 1) * DM + d) * 4); gv_[k] = g[d]; }
#pragma unroll
      for (int k = 0; k < 10; ++k) tab[tid + 512 * k] = wv_[k] * gv_[k]; }
    for (int blk = F.vcu; blk < T / 128; blk += F.G) {
        if (tid < 32) lcnt[tid] = 0;
        __syncthreads();
        f32x4 vq[4][4];
#pragma unroll
        for (int u = 0; u < 4; ++u) { const f32x4* xr = (const f32x4*)(X + (size_t)(blk * 128 + wid * 16 + u) * DM) + lane;
#pragma unroll
          for (int j = 0; j < 4; ++j) vq[u][j] = xr[64 * j]; }
#pragma unroll 1
        for (int i0 = 0; i0 < 16; i0 += 4) {
        { constexpr int up = 0;
            f32x4 v[4][4]; float rstd[4]; int mt[4];
#pragma unroll
            for (int t = 0; t < 4; ++t) { const int i = i0 + up + t; mt[t] = blk * 128 + wid * 16 + i;
#pragma unroll
                for (int j = 0; j < 4; ++j) v[t][j] = vq[up + t][j];
                const f32x4* xr = (const f32x4*)(X + (size_t)(i < 12 ? mt[t] + 4 : mt[t]) * DM) + lane;
#pragma unroll
                for (int j = 0; j < 4; ++j) vq[up + t][j] = xr[64 * j]; }
            { float ss_[4];
#pragma unroll
              for (int t = 0; t < 4; ++t) { ss_[t] = 0.f;
#pragma unroll
                for (int j = 0; j < 4; ++j) ss_[t] += (v[t][j].x * v[t][j].x + v[t][j].y * v[t][j].y) + (v[t][j].z * v[t][j].z + v[t][j].w * v[t][j].w); }
#pragma unroll
              for (int t = 0; t < 4; ++t) ss_[t] = wave_sum(ss_[t]);
#pragma unroll
              for (int t = 0; t < 4; ++t) rstd[t] = 1.f / sqrtf(ss_[t] * (1.f / DM) + EPS); }
#pragma unroll
            for (int t = 0; t < 4; ++t) { unsigned* o8 = (unsigned*)((unsigned char*)H + (size_t)mt[t] * DM) + lane;
#pragma unroll
                for (int j = 0; j < 4; ++j) { const f32x4 gg = ((const f32x4*)g)[lane + 64 * j]; const f32x4 tt = v[t][j] * rstd[t] * gg; o8[64 * j] = pk4_fp8(tt.x, tt.y, tt.z, tt.w); } }
            f32x4 lg[4];
#pragma unroll
            for (int t = 0; t < 4; ++t) lg[t] = f32x4{0.f, 0.f, 0.f, 0.f};
#pragma unroll
            for (int jj = 0; jj < 16; ++jj) { const f32x4 w = tab[jj * 64 + lane];
#pragma unroll
                for (int t = 0; t < 4; ++t) lg[t] += v[t][jj >> 2][jj & 3] * w; }
#pragma unroll
            for (int t = 0; t < 4; ++t) { lg[t].x = wave_sum(lg[t].x); lg[t].y = wave_sum(lg[t].y); lg[t].z = wave_sum(lg[t].z); lg[t].w = wave_sum(lg[t].w); }
            int gi[4]; float gwt[4];
#pragma unroll
            for (int t = 0; t < 4; ++t) { const f32x4 gl = lg[t] * rstd[t] + *(const LAS f32x4*)lbias;
                int gi_ = 0; float gm = gl.x;
                if (gl.y > gm) { gm = gl.y; gi_ = 1; }
                if (gl.z > gm) { gm = gl.z; gi_ = 2; }
                if (gl.w > gm) { gm = gl.w; gi_ = 3; }
                const float den = __expf(gl.x - gm) + __expf(gl.y - gm) + __expf(gl.z - gm) + __expf(gl.w - gm);
                gwt[t] = 1.f / den; gi[t] = __builtin_amdgcn_readfirstlane(gi_); }
            f32x4 le[4];
#pragma unroll
            for (int t = 0; t < 4; ++t) le[t] = f32x4{0.f, 0.f, 0.f, 0.f};
#pragma unroll
            for (int jj = 0; jj < 16; ++jj) {
#pragma unroll
                for (int t = 0; t < 4; ++t) le[t] += v[t][jj >> 2][jj & 3] * tab[(1 + gi[t]) * 1024 + jj * 64 + lane]; }
#pragma unroll
            for (int t = 0; t < 4; ++t) { le[t].x = wave_sum(le[t].x); le[t].y = wave_sum(le[t].y); le[t].z = wave_sum(le[t].z); le[t].w = wave_sum(le[t].w); }
            int qq[4]; float wl_[4], wh_[4];
#pragma unroll
            for (int t = 0; t < 4; ++t) { const f32x4 el = le[t] * rstd[t] + *(const LAS f32x4*)(lbias + 4 + gi[t] * 4);
                int i1 = 0; float v1 = el.x;
                if (el.y > v1) { v1 = el.y; i1 = 1; }
                if (el.z > v1) { v1 = el.z; i1 = 2; }
                if (el.w > v1) { v1 = el.w; i1 = 3; }
                int i2 = -1; float v2 = -3.0e38f;
                if (i1 != 0 && el.x > v2) { v2 = el.x; i2 = 0; }
                if (i1 != 1 && el.y > v2) { v2 = el.y; i2 = 1; }
                if (i1 != 2 && el.z > v2) { v2 = el.z; i2 = 2; }
                if (i1 != 3 && el.w > v2) { v2 = el.w; i2 = 3; }
                const float e2 = __expf(v2 - v1); const float w1 = gwt[t] / (1.f + e2), w2 = gwt[t] * e2 / (1.f + e2);
                const int lo = i1 < i2 ? i1 : i2, hi = i1 < i2 ? i2 : i1; wl_[t] = i1 < i2 ? w1 : w2; wh_[t] = i1 < i2 ? w2 : w1;
                const int pr = lo == 0 ? hi - 1 : (lo == 1 ? hi + 1 : 5); qq[t] = gi[t] * 6 + pr; }
            if (lane == 0) {
#pragma unroll
                for (int t = 0; t < 4; ++t) { const int k = wid * 16 + i0 + up + t; tq[k] = qq[t]; trank[k] = __hip_atomic_fetch_add(&lcnt[qq[t]], 1, __ATOMIC_RELAXED, __HIP_MEMORY_SCOPE_WORKGROUP); twl[2 * k] = wl_[t]; twl[2 * k + 1] = wh_[t]; } }
        } }
        __syncthreads();
        if (tid < NBUCKET && !a.dry) lbase[tid] = (int)atomicAdd(&cnt[tid], (unsigned)lcnt[tid]);
        __syncthreads();
        if (tid < 128 && !a.dry) { const int m = blk * 128 + tid, q = tq[tid]; list[q * LISTCAP + lbase[q] + trank[tid]] = m; tw[2 * m] = twl[2 * tid]; tw[2 * m + 1] = twl[2 * tid + 1]; }
        __syncthreads();
    }
}
__device__ __forceinline__ void moe_table(Frame& F, int layer) {
    if (F.tid == 0) { volatile LAS int* tp = (volatile LAS int*)(F.MISC + 16); int acc = 0;
        for (int q = 0; q < 24; ++q) { const int c = (int)__hip_atomic_load(F.ctl + CW_CNT + layer * 32 + q, __ATOMIC_RELAXED, __HIP_MEMORY_SCOPE_AGENT); tp[q] = acc; tp[32 + q] = c; acc += (c + 255) >> 8; }
        tp[24] = acc; }
    __syncthreads();
}

__device__ __forceinline__ void phase_attnA_naive(Frame& F, const Args& a) {
    const bf16* PAC = (const bf16*)(a.ws + WS_P); float* OA = (float*)(a.ws + WS_OA); const float* bta = (const float*)(a.ws + WS_BTA);
    LAS float* Ks = (LAS float*)F.lds; LAS float* Vs = Ks + 64 * 64;
    for (int unit = F.vcu; unit < 8 * 4 * 2 * 8; unit += F.G) {
        const int qc = unit & 7, c = (unit >> 3) & 1, h = (unit >> 4) & 3, b = unit >> 6;
        const int qpos = qc * 512 + F.tid; const size_t tok = (size_t)b * SEQ + qpos;
        float q[64], o[128];
        { const bf16* qp = PAC + tok * N_AC + h * 128 + c * 64;
#pragma unroll
          for (int d = 0; d < 64; d += 8) { const v4u w = *(const v4u*)(qp + d);
#pragma unroll
              for (int j = 0; j < 4; ++j) { q[d + 2 * j] = bflo(w[j]) * 0.125f; q[d + 2 * j + 1] = bfhi(w[j]) * 0.125f; } } }
#pragma unroll
        for (int e = 0; e < 128; ++e) o[e] = 0.f;
        float mx = -1e30f, l = 0.f;
        const float* bt = bta + h * 8192 + 4095 - qpos;
        for (int kt = 0; kt < 64; ++kt) {
            __syncthreads();
            { const int key = F.tid >> 3, ch = F.tid & 7; const size_t kr = ((size_t)b * SEQ + kt * 64 + key) * N_AC;
              const v4u w = *(const v4u*)(PAC + kr + 512 + h * 128 + c * 64 + ch * 8);
#pragma unroll
              for (int j = 0; j < 4; ++j) { Ks[key * 64 + ch * 8 + 2 * j] = bflo(w[j]); Ks[key * 64 + ch * 8 + 2 * j + 1] = bfhi(w[j]); }
#pragma unroll
              for (int hh = 0; hh < 2; ++hh) { const v4u u = *(const v4u*)(PAC + kr + 1024 + h * 128 + hh * 64 + ch * 8);
#pragma unroll
                  for (int j = 0; j < 4; ++j) { Vs[key * 128 + hh * 64 + ch * 8 + 2 * j] = bflo(u[j]); Vs[key * 128 + hh * 64 + ch * 8 + 2 * j + 1] = bfhi(u[j]); } } }
            __syncthreads();
#pragma unroll 1
            for (int j = 0; j < 64; ++j) {
                float s = 0.f;
#pragma unroll
                for (int d = 0; d < 64; d += 4) { const f32x4 kv = *(const LAS f32x4*)(Ks + j * 64 + d); s += q[d] * kv.x + q[d + 1] * kv.y + q[d + 2] * kv.z + q[d + 3] * kv.w; }
                s += bt[kt * 64 + j];
                if (s > mx) { const float f = __expf(mx - s); l *= f;
#pragma unroll
                    for (int e = 0; e < 128; ++e) o[e] *= f;
                    mx = s; }
                const float pw = __expf(s - mx); l += pw;
#pragma unroll
                for (int e = 0; e < 128; e += 4) { const f32x4 vv = *(const LAS f32x4*)(Vs + j * 128 + e); o[e] += pw * vv.x; o[e + 1] += pw * vv.y; o[e + 2] += pw * vv.z; o[e + 3] += pw * vv.w; }
            }
        }
        const float il = 1.f / l; float* op = OA + ((size_t)c * T + tok) * 512 + h * 128;
#pragma unroll
        for (int e = 0; e < 128; e += 4) *(f32x4*)(op + e) = (f32x4){o[e] * il, o[e + 1] * il, o[e + 2] * il, o[e + 3] * il};
    }
    __syncthreads();
}
__device__ __forceinline__ void phase_attnA_combine(Frame& F, const Args& a, int layer) {
    const float* OA = (const float*)(a.ws + WS_OA); bf16* Y = (bf16*)(a.ws + WS_Y);
    const float* lp = a.in[4] + layer * 256; const float* sg = a.in[5] + layer * 128;
    const float lam_init = 0.8f - 0.6f * expf(-0.3f * (float)layer);
    const float s01 = wave_sum(lp[F.lane] * lp[64 + F.lane]), s23 = wave_sum(lp[128 + F.lane] * lp[192 + F.lane]);
    const float lam = expf(s01) - expf(s23) + lam_init;
    const int gw = F.vcu * NWAVES + F.wave, NGW = F.G * NWAVES, lane = F.lane;
    for (int m = gw; m < T; m += NGW) {
        const f32x4* p0 = (const f32x4*)(OA + (size_t)m * 512 + lane * 8); const f32x4* p1 = (const f32x4*)(OA + ((size_t)T + m) * 512 + lane * 8);
        float y[8]; { const f32x4 a0 = p0[0], a1 = p0[1], b0 = p1[0], b1 = p1[1];
#pragma unroll
            for (int j = 0; j < 4; ++j) { y[j] = a0[j] - lam * b0[j]; y[4 + j] = a1[j] - lam * b1[j]; } }
        float ss = 0.f;
#pragma unroll
        for (int j = 0; j < 8; ++j) ss += y[j] * y[j];
        ss += __shfl_xor(ss, 1); ss += __shfl_xor(ss, 2); ss += __shfl_xor(ss, 4); ss += __shfl_xor(ss, 8);
        const float r = (1.f / sqrtf(ss * (1.f / 128.f) + EPS)) * (1.f - lam_init);
        const int e0 = (lane & 15) * 8; v4u w;
        w.x = pk2(y[0] * r * sg[e0], y[1] * r * sg[e0 + 1]); w.y = pk2(y[2] * r * sg[e0 + 2], y[3] * r * sg[e0 + 3]);
        w.z = pk2(y[4] * r * sg[e0 + 4], y[5] * r * sg[e0 + 5]); w.w = pk2(y[6] * r * sg[e0 + 6], y[7] * r * sg[e0 + 7]);
        *(v4u*)(Y + (size_t)m * 1536 + lane * 8) = w;
    }
}
namespace da {
constexpr int SHM_V = 64 * 128 * 2, SHM_K = 64 * 64 * 2;
constexpr int NSLOT = 5, LDS_V = 0, LDS_K = NSLOT * SHM_V, LDS_WS = LDS_K + NSLOT * SHM_K, LDS_TAB = LDS_WS + NWAVES * 64 * 4, TABP = 452, LDS_END = LDS_TAB + 4 * TABP * 4;
constexpr float C2 = 1.f;
constexpr float THR2 = 8.f * LOG2E;
#define KSWZ64(row, colB) ((row) * 128 + ((colB) ^ ((((row) >> 1) & 7) << 4)))
#define SBAR() __builtin_amdgcn_sched_barrier(0)
template <int VAR> __device__ __forceinline__ void partialSM(f32x16& p0, f32x16& p1, float& m_reg, float& alpha, float cst) {
    float pmax = p0[0];
#pragma unroll
    for (int r = 1; r < 16; ++r) pmax = fmaxf(pmax, p0[r]);
#pragma unroll
    for (int r = 0; r < 16; ++r) pmax = fmaxf(pmax, p1[r]);
    { auto rr = __builtin_amdgcn_permlane32_swap(__float_as_uint(pmax), __float_as_uint(pmax), false, false); pmax = fmaxf(__uint_as_float(rr[0]), __uint_as_float(rr[1])); }
    pmax = fmaf(pmax, C2, cst);
    float mn;
    if (__builtin_expect(__all(pmax - m_reg <= THR2), 1)) { mn = m_reg; alpha = 1.f; }
    else { mn = fmaxf(m_reg, pmax); alpha = __builtin_amdgcn_exp2f(m_reg - mn); m_reg = mn; }
    const float off = cst - mn;
#pragma unroll
    for (int r = 0; r < 16; ++r) { p0[r] = fmaf(p0[r], C2, off); p1[r] = fmaf(p1[r], C2, off); }
    if (VAR != 3) {
#pragma unroll
    for (int r = 0; r < 16; ++r) p0[r] = __builtin_amdgcn_exp2f(p0[r]); }
}
template <int VAR> __device__ __forceinline__ void finishSM(f32x16& p0, f32x16& p1, float alpha, float& l_reg, bf16x8& pa0, bf16x8& pa1, bf16x8& pa2, bf16x8& pa3) {
    if (VAR != 3) {
#pragma unroll
    for (int r = 0; r < 16; ++r) p1[r] = __builtin_amdgcn_exp2f(p1[r]); }
    float ps = 0.f;
#pragma unroll
    for (int r = 0; r < 16; ++r) ps += p0[r];
#pragma unroll
    for (int r = 0; r < 16; ++r) ps += p1[r];
    { auto rr = __builtin_amdgcn_permlane32_swap(__float_as_uint(ps), __float_as_uint(ps), false, false); ps = __uint_as_float(rr[0]) + __uint_as_float(rr[1]); }
    l_reg = l_reg * alpha + ps;
#define PK4(P, BASE, OUT) do { unsigned a0 = cvt_pk_bf16(P[BASE + 0], P[BASE + 1]), a1 = cvt_pk_bf16(P[BASE + 2], P[BASE + 3]);   \
    unsigned b0 = cvt_pk_bf16(P[BASE + 4], P[BASE + 5]), b1 = cvt_pk_bf16(P[BASE + 6], P[BASE + 7]);                              \
    auto r0 = __builtin_amdgcn_permlane32_swap(a0, b0, false, false); auto r1 = __builtin_amdgcn_permlane32_swap(a1, b1, false, false); \
    v4u w_ = {r0[0], r1[0], r0[1], r1[1]}; OUT = __builtin_bit_cast(bf16x8, w_); } while (0)
    PK4(p0, 0, pa0); PK4(p0, 8, pa1); PK4(p1, 0, pa2); PK4(p1, 8, pa3);
#undef PK4
}
template <int VAR> __device__ __forceinline__ void qkt_load(bf16x8 (&kf)[4], const LAS unsigned char* Ks, int r32, int hi) {
#pragma unroll
    for (int d0 = 0; d0 < 2; ++d0) { const int cb = (d0 * 16 + hi * 8) * 2;
        kf[2 * d0] = *(const LAS bf16x8*)(Ks + KSWZ64(r32, cb)); kf[2 * d0 + 1] = *(const LAS bf16x8*)(Ks + KSWZ64(32 + r32, cb)); }
}
template <int VAR> __device__ __forceinline__ void qkt_mma(f32x16& p0, f32x16& p1, const bf16x8 (&kf)[4], const LAS unsigned char* Ks, const bf16x8* qr, int r32, int hi, const LAS float* tb) {
    if (VAR == 2) { p0 = f32x16{}; p1 = f32x16{}; } else {
#pragma unroll
    for (int g4 = 0; g4 < 4; ++g4) { const f32x4 a = *(const LAS f32x4*)(tb + 8 * g4), b = *(const LAS f32x4*)(tb + 32 + 8 * g4);
        p0[4 * g4] = a.x; p0[4 * g4 + 1] = a.y; p0[4 * g4 + 2] = a.z; p0[4 * g4 + 3] = a.w; p1[4 * g4] = b.x; p1[4 * g4 + 1] = b.y; p1[4 * g4 + 2] = b.z; p1[4 * g4 + 3] = b.w; } }
    bf16x8 kg[4];
#pragma unroll
    for (int d0 = 2; d0 < 4; ++d0) { const int cb = (d0 * 16 + hi * 8) * 2;
        kg[2 * d0 - 4] = *(const LAS bf16x8*)(Ks + KSWZ64(r32, cb)); kg[2 * d0 - 3] = *(const LAS bf16x8*)(Ks + KSWZ64(32 + r32, cb)); }
    if (VAR == 6) return;
#pragma unroll
    for (int d0 = 0; d0 < 2; ++d0) {
        p0 = __builtin_amdgcn_mfma_f32_32x32x16_bf16(kf[2 * d0], qr[d0], p0, 0, 0, 0);
        p1 = __builtin_amdgcn_mfma_f32_32x32x16_bf16(kf[2 * d0 + 1], qr[d0], p1, 0, 0, 0); }
#pragma unroll
    for (int d0 = 2; d0 < 4; ++d0) {
        p0 = __builtin_amdgcn_mfma_f32_32x32x16_bf16(kg[2 * d0 - 4], qr[d0], p0, 0, 0, 0);
        p1 = __builtin_amdgcn_mfma_f32_32x32x16_bf16(kg[2 * d0 - 3], qr[d0], p1, 0, 0, 0); }
}
__device__ __forceinline__ int v_st(int k, int c) { const int kk = (k & ~0xC) | ((k & 4) << 1) | ((k & 8) >> 1); return ((kk >> 3) * 4 + (c >> 5)) * 512 + ((kk & 7) * 32 + (c & 31)) * 2; }
__device__ __forceinline__ int v_rd_base(int lane) { return ((lane & 3) << 3) | (((lane >> 2) & 3) << 6) | (((lane >> 4) & 1) << 5) | (((lane >> 5) & 1) << 8); }
constexpr int v_rd_off(int d0, int ks, int half) { return d0 * 512 + ks * 4096 + half * 2048; }
template <int OFF> __device__ __forceinline__ s16x4 tr_read(int vb) { s16x4 r; asm volatile("ds_read_b64_tr_b16 %0, %1 offset:%2" : "=&v"(r) : "v"(vb), "i"(OFF) : "memory"); return r; }
template <int D0> __device__ __forceinline__ void pv_one(f32x16& od, int vb, bf16x8 pa0, bf16x8 pa1, bf16x8 pa2, bf16x8 pa3) {
    const s16x4 l0 = tr_read<v_rd_off(D0, 0, 0)>(vb), h0 = tr_read<v_rd_off(D0, 0, 1)>(vb), l1 = tr_read<v_rd_off(D0, 1, 0)>(vb), h1 = tr_read<v_rd_off(D0, 1, 1)>(vb);
    const s16x4 l2 = tr_read<v_rd_off(D0, 2, 0)>(vb), h2 = tr_read<v_rd_off(D0, 2, 1)>(vb), l3 = tr_read<v_rd_off(D0, 3, 0)>(vb), h3 = tr_read<v_rd_off(D0, 3, 1)>(vb);
    asm volatile("s_waitcnt lgkmcnt(0)" ::: "memory"); SBAR();
#define PKV(L, H) (bf16x8){L[0], L[1], L[2], L[3], H[0], H[1], H[2], H[3]}
    od = __builtin_amdgcn_mfma_f32_32x32x16_bf16(pa0, PKV(l0, h0), od, 0, 0, 0);
    od = __builtin_amdgcn_mfma_f32_32x32x16_bf16(pa1, PKV(l1, h1), od, 0, 0, 0);
    od = __builtin_amdgcn_mfma_f32_32x32x16_bf16(pa2, PKV(l2, h2), od, 0, 0, 0);
    od = __builtin_amdgcn_mfma_f32_32x32x16_bf16(pa3, PKV(l3, h3), od, 0, 0, 0);
#undef PKV
}
__device__ __forceinline__ void pv_d0(f32x16* o, int vb, bf16x8 pa0, bf16x8 pa1, bf16x8 pa2, bf16x8 pa3) {
    pv_one<0>(o[0], vb, pa0, pa1, pa2, pa3); pv_one<1>(o[1], vb, pa0, pa1, pa2, pa3); pv_one<2>(o[2], vb, pa0, pa1, pa2, pa3); pv_one<3>(o[3], vb, pa0, pa1, pa2, pa3);
}
template <int VAR> __device__ __forceinline__ void pass(const bf16* __restrict__ Qw, const bf16* __restrict__ Kh, const bf16* __restrict__ Vh, LAS unsigned char* lds, f32x16 (&o)[4], float& l_out,
                                     int tid, int wid, int lane, int r32, int hi, int qw0, float cL, float cR) {
    LAS unsigned char* V_lds = lds + LDS_V; LAS unsigned char* K_lds = lds + LDS_K;
    LAS float* al_l = (LAS float*)(lds + LDS_WS) + wid * 64 + 32;
    const LAS float* tab = (const LAS float*)(lds + LDS_TAB);
    float m_reg = -1e30f, l_reg = 0.f;
#pragma unroll
    for (int d = 0; d < 4; ++d) o[d] = f32x16{};
    bf16x8 qr[4];
#pragma unroll
    for (int d0 = 0; d0 < 4; ++d0) qr[d0] = *(const bf16x8*)(Qw + (size_t)r32 * N_AC + d0 * 16 + hi * 8);
    const int krow = wid * 8 + (lane >> 3), kcolB = ((lane & 7) * 16) ^ (((krow >> 1) & 7) << 4);
    const unsigned koff = (unsigned)(krow * N_AC) * 2u + (unsigned)kcolB;
    unsigned voff[2];
#pragma unroll
    for (int i = 0; i < 2; ++i) { const int L = i * 8192 + wid * 1024 + lane * 16, st = L >> 9, win = L & 511, kk = (st >> 2) * 8 + (win >> 6), k = (kk & ~0xC) | ((kk & 4) << 1) | ((kk & 8) >> 1), c = (st & 3) * 32 + ((win & 63) >> 1);
        voff[i] = (unsigned)(k * N_AC + c) * 2u; }
    const int vb0 = (int)(uintptr_t)V_lds + v_rd_base(lane);
#define DMA(t, slot) do { const char* kt_ = (const char*)Kh + (size_t)(t) * 64 * N_AC * 2; const char* vt_ = (const char*)Vh + (size_t)(t) * 64 * N_AC * 2; \
    __builtin_amdgcn_global_load_lds((const unsigned*)(kt_ + koff), (LAS unsigned*)(K_lds + (slot) * SHM_K + wid * 1024), 16, 0, 0); \
    __builtin_amdgcn_global_load_lds((const unsigned*)(vt_ + voff[0]), (LAS unsigned*)(V_lds + (slot) * SHM_V + wid * 1024), 16, 0, 0); \
    __builtin_amdgcn_global_load_lds((const unsigned*)(vt_ + voff[1]), (LAS unsigned*)(V_lds + (slot) * SHM_V + 8192 + wid * 1024), 16, 0, 0); } while (0)
#define WAITBAR(N) do { asm volatile("s_waitcnt vmcnt(" #N ") lgkmcnt(0)" ::: "memory"); __builtin_amdgcn_s_barrier(); asm volatile("" ::: "memory"); } while (0)
#define RESC(a) do { if (__any((a) < 1.f)) { if (hi == 0) al_l[r32] = (a); asm volatile("s_waitcnt lgkmcnt(0)" ::: "memory"); \
    _Pragma("unroll") for (int d = 0; d < 4; ++d) _Pragma("unroll") for (int r = 0; r < 16; ++r) o[d][r] *= al_l[crow(r, hi)]; } } while (0)
#define TBIDX(t) (((t) * 64 - qw0) >= 122 ? 384 : (((t) * 64 - qw0) <= -154 ? 0 : ((t) * 64 - qw0 + 224 - r32 + 4 * hi)))
#define TBASE(t) (((TBIDX(t)) & 3) * TABP + ((TBIDX(t)) & ~3))
#define QKL(slot) qkt_load<VAR>(kf, K_lds + (slot) * SHM_K, r32, hi)
#define QKM(P0, P1, slot, t) qkt_mma<VAR>(P0, P1, kf, K_lds + (slot) * SHM_K, qr, r32, hi, tab + TBASE(t))
#define PSM(P0, P1, AL) partialSM<VAR>(P0, P1, m_reg, AL, 0.f)
#define NEXT(x) ((x) == NSLOT - 1 ? 0 : (x) + 1)
    f32x16 pA0, pA1, pB0, pB1; float alA, alB; bf16x8 pa0, pa1, pa2, pa3; constexpr int NT = SEQ / 64;
    int s_m1 = 0, s_0 = 1, s_p2 = 3;
    DMA(0, 0); DMA(1, 1); WAITBAR(3);
    bf16x8 kf[4];
    QKL(0); QKM(pA0, pA1, 0, 0); PSM(pA0, pA1, alA);
    DMA(2, 2); WAITBAR(3);
    if (wid >= 4) WAITBAR(3);
#define STEP(PN0, PN1, PO0, PO1, ALN, ALO, t) do { \
        { const int tt_ = (t) + 2 < NT ? (t) + 2 : NT - 1; DMA(tt_, s_p2); } \
        SBAR(); QKL(s_0); SBAR(); \
        finishSM<VAR>(PO0, PO1, ALO, l_reg, pa0, pa1, pa2, pa3); SBAR(); \
        QKM(PN0, PN1, s_0, t); SBAR(); \
        WAITBAR(3); \
        if (VAR != 4) pv_d0(o, vb0 + s_m1 * SHM_V, pa0, pa1, pa2, pa3); PSM(PN0, PN1, ALN); \
        RESC(ALN); WAITBAR(3); \
        s_m1 = s_0; s_0 = NEXT(s_0); s_p2 = NEXT(s_p2); } while (0)
#pragma unroll 1
    for (int j = 1; j + 1 < NT; j += 2) {
        STEP(pB0, pB1, pA0, pA1, alB, alA, j);
        STEP(pA0, pA1, pB0, pB1, alA, alB, j + 1);
    }
    STEP(pB0, pB1, pA0, pA1, alB, alA, NT - 1);
    if (wid < 4) WAITBAR(3);
    finishSM<VAR>(pB0, pB1, alB, l_reg, pa0, pa1, pa2, pa3); SBAR();
    pv_d0(o, vb0 + s_m1 * SHM_V, pa0, pa1, pa2, pa3);
#undef STEP
#undef NEXT
    l_out = l_reg;
    asm volatile("s_waitcnt vmcnt(0)" ::: "memory");
    __syncthreads();
#undef DMA
#undef WAITBAR
#undef RESC
#undef PSM
#undef QKL
#undef QKM
#undef TBASE
#undef TBIDX
}

constexpr int NKS = 4, NVS = 5, P2_V = 0, P2_K = NVS * SHM_V, P2_WS = P2_K + NKS * SHM_K, P2_TAB = P2_WS + NWAVES * 64 * 4, P2_END = P2_TAB + 4 * TABP * 4;
__device__ __forceinline__ void pass2(const bf16* __restrict__ Qw, const bf16* __restrict__ Kh, const bf16* __restrict__ Vh, LAS unsigned char* lds, f32x16 (&o)[4], float& l_out,
                                      int tid_, int wid, int lane_, int r32_, int hi_, int qw0, float cL, float cR) {
    int tid = threadIdx.x; asm volatile("" : "+v"(tid));
    const int lane = tid & 63, r32 = lane & 31, hi = lane >> 5; (void)tid_; (void)lane_; (void)r32_; (void)hi_;
    LAS unsigned char* V_lds = lds + P2_V; LAS unsigned char* K_lds = lds + P2_K;
    LAS float* al_l = (LAS float*)(lds + P2_WS) + wid * 64 + 32;
    const LAS float* tab = (const LAS float*)(lds + P2_TAB);
    float m_reg = -1e30f, l_reg = 0.f;
#pragma unroll
    for (int d = 0; d < 4; ++d) o[d] = f32x16{};
    bf16x8 qr[4];
#pragma unroll
    for (int d0 = 0; d0 < 4; ++d0) qr[d0] = *(const bf16x8*)(Qw + (size_t)r32 * N_AC + d0 * 16 + hi * 8);
    const int krow = wid * 8 + (lane >> 3), kcolB = ((lane & 7) * 16) ^ (((krow >> 1) & 7) << 4);
    const unsigned koff = (unsigned)(krow * N_AC) * 2u + (unsigned)kcolB;
    unsigned voff[2];
#pragma unroll
    for (int i = 0; i < 2; ++i) { const int L = i * 8192 + wid * 1024 + lane * 16, st = L >> 9, win = L & 511, kk = (st >> 2) * 8 + (win >> 6), k = (kk & ~0xC) | ((kk & 4) << 1) | ((kk & 8) >> 1), c = (st & 3) * 32 + ((win & 63) >> 1);
        voff[i] = (unsigned)(k * N_AC + c) * 2u; }
    const int vb0 = (int)(uintptr_t)V_lds + v_rd_base(lane);
    int kro[4];
#pragma unroll
    for (int d0 = 0; d0 < 4; ++d0) kro[d0] = KSWZ64(r32, (d0 * 16 + hi * 8) * 2);
    constexpr int NT = SEQ / 64;
#define DMAK(t, slot) do { const int tt_ = (t) < NT ? (t) : NT - 1; __builtin_amdgcn_global_load_lds((const unsigned*)((const char*)Kh + (size_t)tt_ * 64 * N_AC * 2 + koff), (LAS unsigned*)(K_lds + (slot) * SHM_K + wid * 1024), 16, 0, 0); } while (0)
#define DMAV(t, slot) do { const int tt_ = (t) < NT ? (t) : NT - 1; const char* vt_ = (const char*)Vh + (size_t)tt_ * 64 * N_AC * 2; \
    __builtin_amdgcn_global_load_lds((const unsigned*)(vt_ + voff[0]), (LAS unsigned*)(V_lds + (slot) * SHM_V + wid * 1024), 16, 0, 0); \
    __builtin_amdgcn_global_load_lds((const unsigned*)(vt_ + voff[1]), (LAS unsigned*)(V_lds + (slot) * SHM_V + 8192 + wid * 1024), 16, 0, 0); } while (0)
#define WAITBAR(N) do { asm volatile("s_waitcnt vmcnt(" #N ") lgkmcnt(0)" ::: "memory"); __builtin_amdgcn_s_barrier(); asm volatile("" ::: "memory"); } while (0)
#define TBIDX(t) (((t) * 64 - qw0) >= 122 ? 384 : (((t) * 64 - qw0) <= -154 ? 0 : ((t) * 64 - qw0 + 224 - r32 + 4 * hi)))
#define TBASE(t) (((TBIDX(t)) & 3) * TABP + ((TBIDX(t)) & ~3))
#define KFRAG(i, kb) (*(const LAS bf16x8*)((kb) + kro[(i) >> 1] + ((i) & 1) * 4096))
#define BIASLD(P0, P1, t, g4) do { const LAS float* tb_ = tab + TBASE(t); const f32x4 a_ = *(const LAS f32x4*)(tb_ + 8 * (g4)), b_ = *(const LAS f32x4*)(tb_ + 32 + 8 * (g4)); \
    P0[4 * (g4)] = a_.x; P0[4 * (g4) + 1] = a_.y; P0[4 * (g4) + 2] = a_.z; P0[4 * (g4) + 3] = a_.w; P1[4 * (g4)] = b_.x; P1[4 * (g4) + 1] = b_.y; P1[4 * (g4) + 2] = b_.z; P1[4 * (g4) + 3] = b_.w; } while (0)
#define PKV(L, H) (bf16x8){L[0], L[1], L[2], L[3], H[0], H[1], H[2], H[3]}
#define PK4(P, BASE, OUT) do { unsigned a0 = cvt_pk_bf16(P[BASE + 0], P[BASE + 1]), a1 = cvt_pk_bf16(P[BASE + 2], P[BASE + 3]);   \
    unsigned b0 = cvt_pk_bf16(P[BASE + 4], P[BASE + 5]), b1 = cvt_pk_bf16(P[BASE + 6], P[BASE + 7]);                              \
    auto r0 = __builtin_amdgcn_permlane32_swap(a0, b0, false, false); auto r1 = __builtin_amdgcn_permlane32_swap(a1, b1, false, false); \
    v4u w_ = {r0[0], r1[0], r0[1], r1[1]}; OUT = __builtin_bit_cast(bf16x8, w_); } while (0)
#define VRD(LO, HI, i, vb, D0, KS) do { LO[i] = tr_read<v_rd_off(D0, KS, 0)>(vb); HI[i] = tr_read<v_rd_off(D0, KS, 1)>(vb); } while (0)
    f32x16 pA0, pA1, pB0, pB1; float alA = 1.f, alB = 1.f; bf16x8 pa0, pa1, pa2, pa3; bf16x8 kf[8];
    s16x4 rlo[8], rhi[8];
    int sk1 = 1, sk3 = 0, svm1 = 0, sv2 = 3;
    DMAK(0, 0); DMAV(0, 0); DMAK(1, 1); DMAV(1, 1); DMAK(2, 2); DMAV(2, 2); DMAK(3, 3);
    asm volatile("s_waitcnt vmcnt(0)" ::: "memory"); __builtin_amdgcn_s_barrier(); asm volatile("" ::: "memory");
#pragma unroll
    for (int g4 = 0; g4 < 4; ++g4) BIASLD(pA0, pA1, 0, g4);
#pragma unroll
    for (int i = 0; i < 8; ++i) kf[i] = KFRAG(i, K_lds);
#pragma unroll
    for (int i = 0; i < 8; ++i) { if (i & 1) pA1 = __builtin_amdgcn_mfma_f32_32x32x16_bf16(kf[i], qr[i >> 1], pA1, 0, 0, 0); else pA0 = __builtin_amdgcn_mfma_f32_32x32x16_bf16(kf[i], qr[i >> 1], pA0, 0, 0, 0); }
    { float pmax = pA0[0];
#pragma unroll
      for (int r = 1; r < 16; ++r) pmax = fmaxf(pmax, pA0[r]);
#pragma unroll
      for (int r = 0; r < 16; ++r) pmax = fmaxf(pmax, pA1[r]);
      { auto rr = __builtin_amdgcn_permlane32_swap(__float_as_uint(pmax), __float_as_uint(pmax), false, false); pmax = fmaxf(__uint_as_float(rr[0]), __uint_as_float(rr[1])); }
      pmax *= C2; m_reg = pmax; alA = 0.f; const float off = -pmax;
#pragma unroll
      for (int r = 0; r < 16; ++r) { pA0[r] = __builtin_amdgcn_exp2f(fmaf(pA0[r], C2, off)); pA1[r] = __builtin_amdgcn_exp2f(fmaf(pA1[r], C2, off)); } }
#pragma unroll
    for (int i = 0; i < 8; ++i) kf[i] = KFRAG(i, K_lds + SHM_K);
    asm volatile("s_waitcnt lgkmcnt(0)" ::: "memory"); __builtin_amdgcn_s_barrier(); asm volatile("" ::: "memory");
    if (wid >= 4) WAITBAR(3);
    int skp1 = 2; sk3 = 0; svm1 = 0; sv2 = 3; (void)sk1;
#define VF(f) PKV(rlo[(f) & 7], rhi[(f) & 7])
#define VISSUE(f) do { if ((f) < 16) VRD(rlo, rhi, (f) & 7, vbm_, (f) >> 2, (f) & 3); } while (0)
#define LW8() do { asm volatile("s_waitcnt lgkmcnt(8)" ::: "memory"); SBAR(); } while (0)
#define STEP(PN0, PN1, PO0, PO1, ALN, ALO, t) do { \
        DMAK((t) + 3, sk3); DMAV((t) + 2, sv2); \
        const int vbm_ = vb0 + svm1 * SHM_V; const LAS unsigned char* kb_ = K_lds + skp1 * SHM_K; const LAS unsigned char* kc_ = K_lds + (skp1 == 0 ? NKS - 1 : skp1 - 1) * SHM_K; \
        float sacc_ = 0.f; \
          \
        SBAR(); \
        kf[4] = KFRAG(4, kc_); kf[5] = KFRAG(5, kc_); kf[6] = KFRAG(6, kc_); kf[7] = KFRAG(7, kc_); SBAR(); \
        PN0 = __builtin_amdgcn_mfma_f32_32x32x16_bf16(kf[0], qr[0], f32x16{}, 0, 0, 0); sacc_ += (PO0[0] + PO0[1]) + (PO0[2] + PO0[3]); SBAR(); \
        PN1 = __builtin_amdgcn_mfma_f32_32x32x16_bf16(kf[1], qr[0], f32x16{}, 0, 0, 0); sacc_ += (PO0[4] + PO0[5]) + (PO0[6] + PO0[7]); PK4(PO0, 0, pa0); SBAR(); \
        PN0 = __builtin_amdgcn_mfma_f32_32x32x16_bf16(kf[2], qr[1], PN0, 0, 0, 0); sacc_ += (PO0[8] + PO0[9]) + (PO0[10] + PO0[11]); SBAR(); \
        PN1 = __builtin_amdgcn_mfma_f32_32x32x16_bf16(kf[3], qr[1], PN1, 0, 0, 0); sacc_ += (PO0[12] + PO0[13]) + (PO0[14] + PO0[15]); PK4(PO0, 8, pa1); SBAR(); \
        PN0 = __builtin_amdgcn_mfma_f32_32x32x16_bf16(kf[4], qr[2], PN0, 0, 0, 0); VISSUE(0); sacc_ += (PO1[0] + PO1[1]) + (PO1[2] + PO1[3]); SBAR(); \
        PN1 = __builtin_amdgcn_mfma_f32_32x32x16_bf16(kf[5], qr[2], PN1, 0, 0, 0); VISSUE(1); sacc_ += (PO1[4] + PO1[5]) + (PO1[6] + PO1[7]); PK4(PO1, 0, pa2); SBAR(); \
        PN0 = __builtin_amdgcn_mfma_f32_32x32x16_bf16(kf[6], qr[3], PN0, 0, 0, 0); VISSUE(2); sacc_ += (PO1[8] + PO1[9]) + (PO1[10] + PO1[11]); SBAR(); \
        PN1 = __builtin_amdgcn_mfma_f32_32x32x16_bf16(kf[7], qr[3], PN1, 0, 0, 0); VISSUE(3); sacc_ += (PO1[12] + PO1[13]) + (PO1[14] + PO1[15]); PK4(PO1, 8, pa3); SBAR(); \
        { auto rr_ = __builtin_amdgcn_permlane32_swap(__float_as_uint(sacc_), __float_as_uint(sacc_), false, false); sacc_ = __uint_as_float(rr_[0]) + __uint_as_float(rr_[1]); } \
        l_reg = l_reg * ALO + sacc_; \
        WAITBAR(3); SBAR(); \
          \
        const int dl_ = (t) * 64 - qw0; const float cst_ = dl_ >= 122 ? cR : (dl_ <= -154 ? cL : 0.f); \
        if (dl_ < 122 && dl_ > -154) { const LAS float* tb_ = tab + TBASE(t); _Pragma("unroll") for (int g4 = 0; g4 < 4; ++g4) { const f32x4 a_ = *(const LAS f32x4*)(tb_ + 8 * g4), b_ = *(const LAS f32x4*)(tb_ + 32 + 8 * g4); \
            PN0[4 * g4] += a_.x; PN0[4 * g4 + 1] += a_.y; PN0[4 * g4 + 2] += a_.z; PN0[4 * g4 + 3] += a_.w; PN1[4 * g4] += b_.x; PN1[4 * g4 + 1] += b_.y; PN1[4 * g4 + 2] += b_.z; PN1[4 * g4 + 3] += b_.w; } } \
        VISSUE(4); o[0] = __builtin_amdgcn_mfma_f32_32x32x16_bf16(pa0, VF(0), o[0], 0, 0, 0); \
        float pm0_ = fmaxf(fmaxf(PN0[0], PN0[1]), PN0[2]), pm1_ = fmaxf(fmaxf(PN0[3], PN0[4]), PN0[5]); pm0_ = fmaxf(fmaxf(pm0_, PN0[6]), PN0[7]); pm1_ = fmaxf(fmaxf(pm1_, PN0[8]), PN0[9]); SBAR(); \
        VISSUE(5); o[0] = __builtin_amdgcn_mfma_f32_32x32x16_bf16(pa1, VF(1), o[0], 0, 0, 0); \
        pm0_ = fmaxf(fmaxf(pm0_, PN0[10]), PN0[11]); pm1_ = fmaxf(fmaxf(pm1_, PN0[12]), PN0[13]); pm0_ = fmaxf(fmaxf(pm0_, PN0[14]), PN0[15]); pm1_ = fmaxf(fmaxf(pm1_, PN1[0]), PN1[1]); SBAR(); \
        VISSUE(6); o[0] = __builtin_amdgcn_mfma_f32_32x32x16_bf16(pa2, VF(2), o[0], 0, 0, 0); \
        pm0_ = fmaxf(fmaxf(pm0_, PN1[2]), PN1[3]); pm1_ = fmaxf(fmaxf(pm1_, PN1[4]), PN1[5]); pm0_ = fmaxf(fmaxf(pm0_, PN1[6]), PN1[7]); pm1_ = fmaxf(fmaxf(pm1_, PN1[8]), PN1[9]); SBAR(); \
        VISSUE(7); o[0] = __builtin_amdgcn_mfma_f32_32x32x16_bf16(pa3, VF(3), o[0], 0, 0, 0); \
        pm0_ = fmaxf(fmaxf(pm0_, PN1[10]), PN1[11]); pm1_ = fmaxf(fmaxf(pm1_, PN1[12]), PN1[13]); pm0_ = fmaxf(fmaxf(pm0_, PN1[14]), PN1[15]); float pmax_ = fmaxf(pm0_, pm1_); \
        { auto rr_ = __builtin_amdgcn_permlane32_swap(__float_as_uint(pmax_), __float_as_uint(pmax_), false, false); pmax_ = fmaxf(__uint_as_float(rr_[0]), __uint_as_float(rr_[1])); } \
        pmax_ = fmaf(pmax_, C2, cst_); float mn_; \
        if (__builtin_expect(__all(pmax_ - m_reg <= THR2), 1)) { mn_ = m_reg; ALN = 1.f; } else { mn_ = fmaxf(m_reg, pmax_); ALN = __builtin_amdgcn_exp2f(m_reg - mn_); m_reg = mn_; } \
        const float off_ = cst_ - mn_; SBAR(); \
        VISSUE(8);  LW8(); o[1] = __builtin_amdgcn_mfma_f32_32x32x16_bf16(pa0, VF(4), o[1], 0, 0, 0); EX4(PN0, 0); SBAR(); \
        VISSUE(9);  LW8(); o[1] = __builtin_amdgcn_mfma_f32_32x32x16_bf16(pa1, VF(5), o[1], 0, 0, 0); EX4(PN0, 4); SBAR(); \
        VISSUE(10); LW8(); o[1] = __builtin_amdgcn_mfma_f32_32x32x16_bf16(pa2, VF(6), o[1], 0, 0, 0); EX4(PN0, 8); SBAR(); \
        VISSUE(11); LW8(); o[1] = __builtin_amdgcn_mfma_f32_32x32x16_bf16(pa3, VF(7), o[1], 0, 0, 0); EX4(PN0, 12); SBAR(); \
        VISSUE(12); LW8(); o[2] = __builtin_amdgcn_mfma_f32_32x32x16_bf16(pa0, VF(8), o[2], 0, 0, 0);  kf[0] = KFRAG(0, kb_); EX4(PN1, 0); SBAR(); \
        VISSUE(13); LW8(); o[2] = __builtin_amdgcn_mfma_f32_32x32x16_bf16(pa1, VF(9), o[2], 0, 0, 0);  kf[1] = KFRAG(1, kb_); EX2(PN1, 4); SBAR(); \
        VISSUE(14); LW8(); o[2] = __builtin_amdgcn_mfma_f32_32x32x16_bf16(pa2, VF(10), o[2], 0, 0, 0); kf[2] = KFRAG(2, kb_); EX2(PN1, 6); SBAR(); \
        VISSUE(15); LW8(); o[2] = __builtin_amdgcn_mfma_f32_32x32x16_bf16(pa3, VF(11), o[2], 0, 0, 0); kf[3] = KFRAG(3, kb_); EX2(PN1, 8); SBAR(); \
        LW8(); o[3] = __builtin_amdgcn_mfma_f32_32x32x16_bf16(pa0, VF(12), o[3], 0, 0, 0); EX2(PN1, 10); SBAR(); \
        LW8(); o[3] = __builtin_amdgcn_mfma_f32_32x32x16_bf16(pa1, VF(13), o[3], 0, 0, 0); EX2(PN1, 12); SBAR(); \
        LW8(); o[3] = __builtin_amdgcn_mfma_f32_32x32x16_bf16(pa2, VF(14), o[3], 0, 0, 0); EX2(PN1, 14); SBAR(); \
        asm volatile("s_waitcnt lgkmcnt(3)" ::: "memory"); SBAR(); o[3] = __builtin_amdgcn_mfma_f32_32x32x16_bf16(pa3, VF(15), o[3], 0, 0, 0); SBAR(); \
        if (__any(ALN < 1.f)) { if (hi == 0) al_l[r32] = ALN; asm volatile("s_waitcnt lgkmcnt(0)" ::: "memory"); \
            _Pragma("unroll") for (int d = 0; d < 4; ++d) _Pragma("unroll") for (int r = 0; r < 16; ++r) o[d][r] *= al_l[crow(r, hi)]; } \
        WAITBAR(3); \
        skp1 = (skp1 == NKS - 1) ? 0 : skp1 + 1; sk3 = (sk3 == NKS - 1) ? 0 : sk3 + 1; svm1 = (svm1 == NVS - 1) ? 0 : svm1 + 1; sv2 = (sv2 == NVS - 1) ? 0 : sv2 + 1; } while (0)
#define EX4(P, B) do { P[B] = __builtin_amdgcn_exp2f(fmaf(P[B], C2, off_)); P[B + 1] = __builtin_amdgcn_exp2f(fmaf(P[B + 1], C2, off_)); P[B + 2] = __builtin_amdgcn_exp2f(fmaf(P[B + 2], C2, off_)); P[B + 3] = __builtin_amdgcn_exp2f(fmaf(P[B + 3], C2, off_)); } while (0)
#define EX2(P, B) do { P[B] = __builtin_amdgcn_exp2f(fmaf(P[B], C2, off_)); P[B + 1] = __builtin_amdgcn_exp2f(fmaf(P[B + 1], C2, off_)); } while (0)
#pragma unroll 1
    for (int j = 1; j + 1 < NT; j += 2) {
        STEP(pB0, pB1, pA0, pA1, alB, alA, j);
        STEP(pA0, pA1, pB0, pB1, alA, alB, j + 1);
    }
    STEP(pB0, pB1, pA0, pA1, alB, alA, NT - 1);
    if (wid < 4) WAITBAR(3);
    { float sacc = 0.f;
#pragma unroll
      for (int r = 0; r < 16; ++r) sacc += pB0[r] + pB1[r];
      { auto rr = __builtin_amdgcn_permlane32_swap(__float_as_uint(sacc), __float_as_uint(sacc), false, false); sacc = __uint_as_float(rr[0]) + __uint_as_float(rr[1]); }
      l_reg = l_reg * alB + sacc;
      PK4(pB0, 0, pa0); PK4(pB0, 8, pa1); PK4(pB1, 0, pa2); PK4(pB1, 8, pa3); SBAR();
      pv_d0(o, vb0 + svm1 * SHM_V, pa0, pa1, pa2, pa3); }
#undef STEP
#undef EX4
#undef EX2
#undef VF
#undef VISSUE
#undef LW8
    l_out = l_reg;
    asm volatile("s_waitcnt vmcnt(0)" ::: "memory");
    __syncthreads();
#undef DMAK
#undef DMAV
#undef WAITBAR
#undef TBIDX
#undef TBASE
#undef KFRAG
#undef BIASLD
#undef PKV
#undef PK4
#undef VRD
}
__device__ __forceinline__ void pass3(const bf16* __restrict__ Qw, const bf16* __restrict__ Kh, const bf16* __restrict__ Vh, LAS unsigned char* lds, f32x16 (&o)[4], float& l_out,
                                      int tid_, int wid, int lane_, int r32_, int hi_, int qw0) {
    int tid = threadIdx.x; asm volatile("" : "+v"(tid));
    const int lane = tid & 63, r32 = lane & 31, hi = lane >> 5; (void)tid_; (void)lane_; (void)r32_; (void)hi_;
    LAS unsigned char* V_lds = lds + P2_V; LAS unsigned char* K_lds = lds + P2_K;
    const LAS float* tab = (const LAS float*)(lds + P2_TAB);
    float l_reg = 0.f;
#pragma unroll
    for (int d = 0; d < 4; ++d) o[d] = f32x16{};
    bf16x8 qr[4];
#pragma unroll
    for (int d0 = 0; d0 < 4; ++d0) qr[d0] = *(const bf16x8*)(Qw + (size_t)r32 * N_AC + d0 * 16 + hi * 8);
    const int krow = wid * 8 + (lane >> 3), kcolB = ((lane & 7) * 16) ^ (((krow >> 1) & 7) << 4);
    const unsigned koff = (unsigned)(krow * N_AC) * 2u + (unsigned)kcolB;
    unsigned voff[2];
#pragma unroll
    for (int i = 0; i < 2; ++i) { const int L = i * 8192 + wid * 1024 + lane * 16, st = L >> 9, win = L & 511, kk = (st >> 2) * 8 + (win >> 6), k = (kk & ~0xC) | ((kk & 4) << 1) | ((kk & 8) >> 1), c = (st & 3) * 32 + ((win & 63) >> 1);
        voff[i] = (unsigned)(k * N_AC + c) * 2u; }
    const int vb0 = (int)(uintptr_t)V_lds + v_rd_base(lane);
    int kro[4];
#pragma unroll
    for (int d0 = 0; d0 < 4; ++d0) kro[d0] = KSWZ64(r32, (d0 * 16 + hi * 8) * 2);
    constexpr int NT = SEQ / 64;
#define DMAK(t, slot) do { const int tt_ = (t) < NT ? (t) : NT - 1; __builtin_amdgcn_global_load_lds((const unsigned*)((const char*)Kh + (size_t)tt_ * 64 * N_AC * 2 + koff), (LAS unsigned*)(K_lds + (slot) * SHM_K + wid * 1024), 16, 0, 0); } while (0)
#define DMAV(t, slot) do { const int tt_ = (t) < NT ? (t) : NT - 1; const char* vt_ = (const char*)Vh + (size_t)tt_ * 64 * N_AC * 2; \
    __builtin_amdgcn_global_load_lds((const unsigned*)(vt_ + voff[0]), (LAS unsigned*)(V_lds + (slot) * SHM_V + wid * 1024), 16, 0, 0); \
    __builtin_amdgcn_global_load_lds((const unsigned*)(vt_ + voff[1]), (LAS unsigned*)(V_lds + (slot) * SHM_V + 8192 + wid * 1024), 16, 0, 0); } while (0)
#define WAITBAR(N) do { asm volatile("s_waitcnt vmcnt(" #N ") lgkmcnt(0)" ::: "memory"); __builtin_amdgcn_s_barrier(); asm volatile("" ::: "memory"); } while (0)
#define TBIDX(t) (((t) * 64 - qw0) >= 122 ? 384 : (((t) * 64 - qw0) <= -154 ? 0 : ((t) * 64 - qw0 + 224 - r32 + 4 * hi)))
#define TBASE(t) (((TBIDX(t)) & 3) * TABP + ((TBIDX(t)) & ~3))
#define KFRAG(i, kb) (*(const LAS bf16x8*)((kb) + kro[(i) >> 1] + ((i) & 1) * 4096))
#define BIASLD(P0, P1, t, g4) do { const LAS float* tb_ = tab + TBASE(t); const f32x4 a_ = *(const LAS f32x4*)(tb_ + 8 * (g4)), b_ = *(const LAS f32x4*)(tb_ + 32 + 8 * (g4)); \
    P0[4 * (g4)] = a_.x; P0[4 * (g4) + 1] = a_.y; P0[4 * (g4) + 2] = a_.z; P0[4 * (g4) + 3] = a_.w; P1[4 * (g4)] = b_.x; P1[4 * (g4) + 1] = b_.y; P1[4 * (g4) + 2] = b_.z; P1[4 * (g4) + 3] = b_.w; } while (0)
#define PKV(L, H) (bf16x8){L[0], L[1], L[2], L[3], H[0], H[1], H[2], H[3]}
#define PK4(P, BASE, OUT) do { unsigned a0 = cvt_pk_bf16(P[BASE + 0], P[BASE + 1]), a1 = cvt_pk_bf16(P[BASE + 2], P[BASE + 3]);   \
    unsigned b0 = cvt_pk_bf16(P[BASE + 4], P[BASE + 5]), b1 = cvt_pk_bf16(P[BASE + 6], P[BASE + 7]);                              \
    auto r0 = __builtin_amdgcn_permlane32_swap(a0, b0, false, false); auto r1 = __builtin_amdgcn_permlane32_swap(a1, b1, false, false); \
    v4u w_ = {r0[0], r1[0], r0[1], r1[1]}; OUT = __builtin_bit_cast(bf16x8, w_); } while (0)
#define VRD(LO, HI, i, vb, D0, KS) do { LO[i] = tr_read<v_rd_off(D0, KS, 0)>(vb); HI[i] = tr_read<v_rd_off(D0, KS, 1)>(vb); } while (0)
    f32x16 pA0, pA1, pB0, pB1; bf16x8 pa0, pa1, pa2, pa3; bf16x8 kf[8];
    s16x4 rlo[8], rhi[8];
    int sk1 = 1, sk3 = 0, svm1 = 0, sv2 = 3;
    DMAK(0, 0); DMAV(0, 0); DMAK(1, 1); DMAV(1, 1); DMAK(2, 2); DMAV(2, 2); DMAK(3, 3);
    asm volatile("s_waitcnt vmcnt(0)" ::: "memory"); __builtin_amdgcn_s_barrier(); asm volatile("" ::: "memory");
    if (qw0 < 154) {
#pragma unroll
      for (int g4 = 0; g4 < 4; ++g4) BIASLD(pA0, pA1, 0, g4); }
    else { pA0 = f32x16{}; pA1 = f32x16{}; }
#pragma unroll
    for (int i = 0; i < 8; ++i) kf[i] = KFRAG(i, K_lds);
#pragma unroll
    for (int i = 0; i < 8; ++i) { if (i & 1) pA1 = __builtin_amdgcn_mfma_f32_32x32x16_bf16(kf[i], qr[i >> 1], pA1, 0, 0, 0); else pA0 = __builtin_amdgcn_mfma_f32_32x32x16_bf16(kf[i], qr[i >> 1], pA0, 0, 0, 0); }
#pragma unroll
    for (int r = 0; r < 16; ++r) { pA0[r] = __builtin_amdgcn_exp2f(pA0[r]); pA1[r] = __builtin_amdgcn_exp2f(pA1[r]); }
#pragma unroll
    for (int i = 0; i < 8; ++i) kf[i] = KFRAG(i, K_lds + SHM_K);
    asm volatile("s_waitcnt lgkmcnt(0)" ::: "memory"); __builtin_amdgcn_s_barrier(); asm volatile("" ::: "memory");
    if (wid >= 4) WAITBAR(3);
    int skp1 = 2; sk3 = 0; svm1 = 0; sv2 = 3; (void)sk1;
#define VF(f) PKV(rlo[(f) & 7], rhi[(f) & 7])
#define VISSUE(f) do { if ((f) < 16) VRD(rlo, rhi, (f) & 7, vbm_, (f) >> 2, (f) & 3); } while (0)
#define LW8() do { asm volatile("s_waitcnt lgkmcnt(8)" ::: "memory"); SBAR(); } while (0)
#define LW12() do { asm volatile("s_waitcnt lgkmcnt(12)" ::: "memory"); SBAR(); } while (0)
#define STEP(PN0, PN1, PO0, PO1, t) do { \
        DMAK((t) + 3, sk3); DMAV((t) + 2, sv2); \
        const int vbm_ = vb0 + svm1 * SHM_V; const LAS unsigned char* kb_ = K_lds + skp1 * SHM_K; const LAS unsigned char* kc_ = K_lds + (skp1 == 0 ? NKS - 1 : skp1 - 1) * SHM_K; \
        float sacc_ = 0.f; \
          \
        SBAR(); \
          \
        PN0 = __builtin_amdgcn_mfma_f32_32x32x16_bf16(kf[0], qr[0], f32x16{}, 0, 0, 0); kf[4] = KFRAG(4, kc_); kf[5] = KFRAG(5, kc_); sacc_ += (PO0[0] + PO0[1]) + (PO0[2] + PO0[3]); SBAR(); \
        PN1 = __builtin_amdgcn_mfma_f32_32x32x16_bf16(kf[1], qr[0], f32x16{}, 0, 0, 0); kf[6] = KFRAG(6, kc_); kf[7] = KFRAG(7, kc_); sacc_ += (PO0[4] + PO0[5]) + (PO0[6] + PO0[7]); PK4(PO0, 0, pa0); SBAR(); \
        PN0 = __builtin_amdgcn_mfma_f32_32x32x16_bf16(kf[2], qr[1], PN0, 0, 0, 0); VISSUE(0); sacc_ += (PO0[8] + PO0[9]) + (PO0[10] + PO0[11]); SBAR(); \
        PN1 = __builtin_amdgcn_mfma_f32_32x32x16_bf16(kf[3], qr[1], PN1, 0, 0, 0); VISSUE(1); sacc_ += (PO0[12] + PO0[13]) + (PO0[14] + PO0[15]); PK4(PO0, 8, pa1); SBAR(); \
        PN0 = __builtin_amdgcn_mfma_f32_32x32x16_bf16(kf[4], qr[2], PN0, 0, 0, 0); VISSUE(2); sacc_ += (PO1[0] + PO1[1]) + (PO1[2] + PO1[3]); SBAR(); \
        PN1 = __builtin_amdgcn_mfma_f32_32x32x16_bf16(kf[5], qr[2], PN1, 0, 0, 0); VISSUE(3); sacc_ += (PO1[4] + PO1[5]) + (PO1[6] + PO1[7]); PK4(PO1, 0, pa2); SBAR(); \
        PN0 = __builtin_amdgcn_mfma_f32_32x32x16_bf16(kf[6], qr[3], PN0, 0, 0, 0); VISSUE(4); sacc_ += (PO1[8] + PO1[9]) + (PO1[10] + PO1[11]); SBAR(); \
        PN1 = __builtin_amdgcn_mfma_f32_32x32x16_bf16(kf[7], qr[3], PN1, 0, 0, 0); VISSUE(5); sacc_ += (PO1[12] + PO1[13]) + (PO1[14] + PO1[15]); PK4(PO1, 8, pa3); SBAR(); \
        { auto rr_ = __builtin_amdgcn_permlane32_swap(__float_as_uint(sacc_), __float_as_uint(sacc_), false, false); sacc_ = __uint_as_float(rr_[0]) + __uint_as_float(rr_[1]); } \
        l_reg += sacc_; \
        WAITBAR(3); SBAR(); \
          \
        const int dl_ = (t) * 64 - qw0; \
        if (dl_ < 122 && dl_ > -154) { const LAS float* tb_ = tab + TBASE(t); _Pragma("unroll") for (int g4 = 0; g4 < 4; ++g4) { const f32x4 a_ = *(const LAS f32x4*)(tb_ + 8 * g4), b_ = *(const LAS f32x4*)(tb_ + 32 + 8 * g4); \
            PN0[4 * g4] += a_.x; PN0[4 * g4 + 1] += a_.y; PN0[4 * g4 + 2] += a_.z; PN0[4 * g4 + 3] += a_.w; PN1[4 * g4] += b_.x; PN1[4 * g4 + 1] += b_.y; PN1[4 * g4 + 2] += b_.z; PN1[4 * g4 + 3] += b_.w; } } \
        VISSUE(6);  LW12(); o[0] = __builtin_amdgcn_mfma_f32_32x32x16_bf16(pa0, VF(0), o[0], 0, 0, 0); SBAR(); \
        VISSUE(7);  LW12(); o[0] = __builtin_amdgcn_mfma_f32_32x32x16_bf16(pa1, VF(1), o[0], 0, 0, 0); EX2(PN0, 0); SBAR(); \
        VISSUE(8);  LW12(); o[0] = __builtin_amdgcn_mfma_f32_32x32x16_bf16(pa2, VF(2), o[0], 0, 0, 0); EX2(PN0, 2); SBAR(); \
        VISSUE(9);  LW12(); o[0] = __builtin_amdgcn_mfma_f32_32x32x16_bf16(pa3, VF(3), o[0], 0, 0, 0); EX2(PN0, 4); SBAR(); \
        VISSUE(10); LW12(); o[1] = __builtin_amdgcn_mfma_f32_32x32x16_bf16(pa0, VF(4), o[1], 0, 0, 0); EX2(PN0, 6); SBAR(); \
        VISSUE(11); LW12(); o[1] = __builtin_amdgcn_mfma_f32_32x32x16_bf16(pa1, VF(5), o[1], 0, 0, 0); EX2(PN0, 8); SBAR(); \
        VISSUE(12); LW12(); o[1] = __builtin_amdgcn_mfma_f32_32x32x16_bf16(pa2, VF(6), o[1], 0, 0, 0); EX2(PN0, 10); SBAR(); \
        VISSUE(13); LW12(); o[1] = __builtin_amdgcn_mfma_f32_32x32x16_bf16(pa3, VF(7), o[1], 0, 0, 0); EX4(PN0, 12); SBAR(); \
        VISSUE(14); LW12(); o[2] = __builtin_amdgcn_mfma_f32_32x32x16_bf16(pa0, VF(8), o[2], 0, 0, 0);  EX2(PN1, 0); SBAR(); \
        VISSUE(15); LW12(); o[2] = __builtin_amdgcn_mfma_f32_32x32x16_bf16(pa1, VF(9), o[2], 0, 0, 0);  EX2(PN1, 2); SBAR(); \
        kf[0] = KFRAG(0, kb_); asm volatile("s_waitcnt lgkmcnt(11)" ::: "memory"); SBAR(); o[2] = __builtin_amdgcn_mfma_f32_32x32x16_bf16(pa2, VF(10), o[2], 0, 0, 0); EX2(PN1, 4); SBAR(); \
        kf[1] = KFRAG(1, kb_); asm volatile("s_waitcnt lgkmcnt(10)" ::: "memory"); SBAR(); o[2] = __builtin_amdgcn_mfma_f32_32x32x16_bf16(pa3, VF(11), o[2], 0, 0, 0); EX2(PN1, 6); SBAR(); \
        kf[2] = KFRAG(2, kb_); asm volatile("s_waitcnt lgkmcnt(9)" ::: "memory"); SBAR(); o[3] = __builtin_amdgcn_mfma_f32_32x32x16_bf16(pa0, VF(12), o[3], 0, 0, 0); EX2(PN1, 8); SBAR(); \
        kf[3] = KFRAG(3, kb_); asm volatile("s_waitcnt lgkmcnt(8)" ::: "memory"); SBAR(); o[3] = __builtin_amdgcn_mfma_f32_32x32x16_bf16(pa1, VF(13), o[3], 0, 0, 0); EX2(PN1, 10); SBAR(); \
        asm volatile("s_waitcnt lgkmcnt(6)" ::: "memory"); SBAR(); o[3] = __builtin_amdgcn_mfma_f32_32x32x16_bf16(pa2, VF(14), o[3], 0, 0, 0); EX4(PN1, 12); SBAR(); \
        asm volatile("s_waitcnt lgkmcnt(4)" ::: "memory"); SBAR(); o[3] = __builtin_amdgcn_mfma_f32_32x32x16_bf16(pa3, VF(15), o[3], 0, 0, 0); SBAR(); \
        if (dl_ > -154 && dl_ <= -90) { const float fL = ((const LAS float*)(lds + P2_END))[0]; l_reg *= fL; _Pragma("unroll") for (int d = 0; d < 4; ++d) _Pragma("unroll") for (int r = 0; r < 16; ++r) o[d][r] *= fL; }             \
        else if (dl_ >= 122 && dl_ < 186) { const float fRi = ((const LAS float*)(lds + P2_END))[1]; l_reg *= fRi; _Pragma("unroll") for (int d = 0; d < 4; ++d) _Pragma("unroll") for (int r = 0; r < 16; ++r) o[d][r] *= fRi; }       \
        WAITBAR(3); \
        skp1 = (skp1 == NKS - 1) ? 0 : skp1 + 1; sk3 = (sk3 == NKS - 1) ? 0 : sk3 + 1; svm1 = (svm1 == NVS - 1) ? 0 : svm1 + 1; sv2 = (sv2 == NVS - 1) ? 0 : sv2 + 1; } while (0)
#define EX4(P, B) do { P[B] = __builtin_amdgcn_exp2f(P[B]); P[B + 1] = __builtin_amdgcn_exp2f(P[B + 1]); P[B + 2] = __builtin_amdgcn_exp2f(P[B + 2]); P[B + 3] = __builtin_amdgcn_exp2f(P[B + 3]); } while (0)
#define EX2(P, B) do { P[B] = __builtin_amdgcn_exp2f(P[B]); P[B + 1] = __builtin_amdgcn_exp2f(P[B + 1]); } while (0)
#pragma unroll 1
    for (int j = 1; j + 1 < NT; j += 2) {
        STEP(pB0, pB1, pA0, pA1, j);
        STEP(pA0, pA1, pB0, pB1, j + 1);
    }
    STEP(pB0, pB1, pA0, pA1, NT - 1);
    if (wid < 4) WAITBAR(3);
    { float sacc = 0.f;
#pragma unroll
      for (int r = 0; r < 16; ++r) sacc += pB0[r] + pB1[r];
      { auto rr = __builtin_amdgcn_permlane32_swap(__float_as_uint(sacc), __float_as_uint(sacc), false, false); sacc = __uint_as_float(rr[0]) + __uint_as_float(rr[1]); }
      l_reg += sacc;
      PK4(pB0, 0, pa0); PK4(pB0, 8, pa1); PK4(pB1, 0, pa2); PK4(pB1, 8, pa3); SBAR();
      pv_d0(o, vb0 + svm1 * SHM_V, pa0, pa1, pa2, pa3); }
#undef STEP
#undef EX4
#undef EX2
#undef VF
#undef VISSUE
#undef LW8
#undef LW12
    l_out = l_reg;
    asm volatile("s_waitcnt vmcnt(0)" ::: "memory");
    __syncthreads();
#undef DMAK
#undef DMAV
#undef WAITBAR
#undef TBIDX
#undef TBASE
#undef KFRAG
#undef BIASLD
#undef PKV
#undef PK4
#undef VRD
}
#undef SBAR
}
__device__ __forceinline__ bool wg_any(Frame& F, bool pred) {
    if (pred) F.MISC[12] = 1u;
    __syncthreads();
    const unsigned f = F.MISC[12];
    __syncthreads();
    if (f && F.tid == 0) F.MISC[12] = 0u;
    return f != 0u;
}
template <int VAR> __device__ __forceinline__ void phase_attnA(Frame& F, const Args& a, int layer) {
    const bf16* PAC = (const bf16*)(a.ws + WS_P); float* OS = (float*)(a.ws + WS_OA); const float* bta = (const float*)(a.ws + WS_BTA); bf16* Y = (bf16*)(a.ws + WS_Y);
    const float* lp = a.in[4] + layer * 256; const float* sg = a.in[5] + layer * 128;
    const float lam_init = 0.8f - 0.6f * expf(-0.3f * (float)layer);
    const float s01 = wave_sum(lp[F.lane] * lp[64 + F.lane]), s23 = wave_sum(lp[128 + F.lane] * lp[192 + F.lane]);
    const float lam = expf(s01) - expf(s23) + lam_init;
    const int tid = F.tid, lane = F.lane, wid = F.wave, r32 = lane & 31, hi = lane >> 5;
    LAS float* tab = (LAS float*)(F.lds + da::P2_TAB); LAS float* li_l = (LAS float*)(F.lds + da::P2_WS) + wid * 64;
    const char* osb = (const char*)(OS + (size_t)blockIdx.x * (64 * 512));
    for (int unit = F.vcu; unit < BATCH * 4 * 16; unit += F.G) {
        const int qb = unit & 15, h = (unit >> 4) & 3, b = unit >> 6;
        __syncthreads();
        for (int i = tid; i < 4 * da::TABP; i += 512) { const int c = i / da::TABP, j = i % da::TABP; int rel = j + c - 224; rel = rel < -160 ? -160 : (rel > 159 ? 159 : rel); tab[i] = bta[h * 8192 + 4095 + rel] * LOG2E; }
        if (tid == 0) { const float cL = bta[h * 8192] * LOG2E, cR = bta[h * 8192 + 8190] * LOG2E; LAS float* fc = (LAS float*)(F.lds + da::P2_END);
            fc[0] = __builtin_amdgcn_exp2f(cL); fc[1] = __builtin_amdgcn_exp2f(-cR); fc[2] = cL; fc[3] = cR; }
        __syncthreads();
        const size_t rowb = (size_t)b * SEQ; const int qw0 = qb * 256 + wid * 32;
        f32x16 o[4]; float l;
        da::pass3(PAC + (rowb + qw0) * N_AC + h * 128, PAC + rowb * N_AC + 512 + h * 128, PAC + rowb * N_AC + 1024 + h * 128, F.lds, o, l, tid, wid, lane, r32, hi, qw0);
        if (wg_any(F, !(l > 0x1p-100f && l < 0x1p100f)))
            da::pass2(PAC + (rowb + qw0) * N_AC + h * 128, PAC + rowb * N_AC + 512 + h * 128, PAC + rowb * N_AC + 1024 + h * 128, F.lds, o, l, tid, wid, lane, r32, hi, qw0, ((const LAS float*)(F.lds + da::P2_END))[2], ((const LAS float*)(F.lds + da::P2_END))[3]);
        if (hi == 0) li_l[r32] = l;
        LDS_WAIT();
        { int t_ = threadIdx.x; asm volatile("" : "+v"(t_)); char* pp = (char*)osb + (unsigned)t_ * 4u;
#pragma unroll
          for (int r = 0; r < 16; ++r) { const float il = __builtin_amdgcn_rcpf(li_l[crow(r, hi)]);
#pragma unroll
            for (int d0 = 0; d0 < 4; ++d0) { *(float*)pp = o[d0][r] * il; pp += 2048; asm volatile("" : "+v"(pp)); } } }
        LDS_WAIT();
        da::pass3(PAC + (rowb + qw0) * N_AC + h * 128 + 64, PAC + rowb * N_AC + 512 + h * 128 + 64, PAC + rowb * N_AC + 1024 + h * 128, F.lds, o, l, tid, wid, lane, r32, hi, qw0);
        if (wg_any(F, !(l > 0x1p-100f && l < 0x1p100f)))
            da::pass2(PAC + (rowb + qw0) * N_AC + h * 128 + 64, PAC + rowb * N_AC + 512 + h * 128 + 64, PAC + rowb * N_AC + 1024 + h * 128, F.lds, o, l, tid, wid, lane, r32, hi, qw0, ((const LAS float*)(F.lds + da::P2_END))[2], ((const LAS float*)(F.lds + da::P2_END))[3]);
        if (hi == 0) li_l[r32] = l;
        LDS_WAIT();
        float sgv[4];
#pragma unroll
        for (int d0 = 0; d0 < 4; ++d0) sgv[d0] = sg[d0 * 32 + r32] * (1.f - lam_init);
        { int t_ = threadIdx.x; asm volatile("" : "+v"(t_)); const char* pp = osb + (unsigned)t_ * 4u; char* yp = (char*)(Y + (rowb + qw0) * 1536 + h * 128) + (unsigned)(4 * ((t_ >> 5) & 1) * 1536 + (t_ & 31)) * 2u;
#pragma unroll
          for (int r = 0; r < 16; ++r) { const float il = __builtin_amdgcn_rcpf(li_l[crow(r, hi)]); float y[4]; float ss = 0.f;
#pragma unroll
            for (int d0 = 0; d0 < 4; ++d0) { y[d0] = *(const float*)pp - lam * (o[d0][r] * il); ss += y[d0] * y[d0]; pp += 2048; asm volatile("" : "+v"(pp)); }
            ss = half_sum(ss, hi);
            const float rs = 1.f / sqrtf(ss * (1.f / 128.f) + EPS);
            if (!a.dry) {
#pragma unroll
              for (int d0 = 0; d0 < 4; ++d0) *(bf16*)(yp + d0 * 64) = (bf16)f2bf(y[d0] * rs * sgv[d0]); } else asm volatile("" :: "v"(y[0]), "v"(y[1]), "v"(y[2]), "v"(y[3]), "v"(rs));
            yp += ((r & 3) == 3 ? 5 : 1) * 3072; asm volatile("" : "+v"(yp)); } }
        LDS_WAIT();
    }
    __syncthreads();
}
__device__ __forceinline__ float gelu_tanh(float x) { const float x2 = x * x; const float t = x * fmaf(x2, -2.f * 0.7978845608028654f * 0.044715f * LOG2E, -2.f * 0.7978845608028654f * LOG2E);
    return x * __builtin_amdgcn_rcpf(1.f + __builtin_amdgcn_exp2f(t)); }
__device__ __forceinline__ void phase_sgu_ln(Frame& F, const Args& a, int layer) {
    const bf16* PAC = (const bf16*)(a.ws + WS_P); bf16* Y = (bf16*)(a.ws + WS_Y);
    const float* lg = a.in[6] + layer * 512; const float* lb = a.in[7] + layer * 512;
    const int gw = F.vcu * NWAVES + F.wave, NGW = F.G * NWAVES, lane = F.lane;
    for (int m = gw; m < T; m += NGW) {
        const v4u w = *(const v4u*)(PAC + (size_t)m * N_AC + 2048 + lane * 8); float v[8];
#pragma unroll
        for (int j = 0; j < 4; ++j) { v[2 * j] = gelu_tanh(bflo(w[j])); v[2 * j + 1] = gelu_tanh(bfhi(w[j])); }
        float s = 0.f;
#pragma unroll
        for (int j = 0; j < 8; ++j) s += v[j];
        const float mu = wave_sum(s) * (1.f / 512.f); float s2 = 0.f;
#pragma unroll
        for (int j = 0; j < 8; ++j) { v[j] -= mu; s2 += v[j] * v[j]; }
        const float rstd = 1.f / sqrtf(wave_sum(s2) * (1.f / 512.f) + EPS);
        v4u o;
#pragma unroll
        for (int j = 0; j < 4; ++j) { const int c0 = lane * 8 + 2 * j; o[j] = pk2(v[2 * j] * rstd * lg[c0] + lb[c0], v[2 * j + 1] * rstd * lg[c0 + 1] + lb[c0 + 1]); }
        *(v4u*)(Y + (size_t)m * 1536 + 512 + lane * 8) = o;
    }
}
__device__ __forceinline__ void phase_sgu_mix(Frame& F, const Args& a, int layer) {
    const bf16* PAC = (const bf16*)(a.ws + WS_P); bf16* Y = (bf16*)(a.ws + WS_Y);
    const float* ws_ = a.in[8] + (size_t)layer * 4 * 128 * 128; const float* bs = a.in[9] + layer * 4 * 128;
    LAS bf16* vl = (LAS bf16*)F.lds;
    for (int ch = F.vcu; ch < T / 128; ch += F.G) {
        __syncthreads();
        for (int i = F.tid; i < 128 * 64; i += 512) { const int qq = i >> 6, c8 = i & 63; *(LAS v4u*)(vl + qq * 512 + c8 * 8) = *(const v4u*)(Y + ((size_t)ch * 128 + qq) * 1536 + 512 + c8 * 8); }
        __syncthreads();
        const int c = F.tid, g = c >> 7; const float* wg = ws_ + (size_t)g * 128 * 128;
#pragma unroll 1
        for (int p0 = 0; p0 < 128; p0 += 8) {
            float acc[8];
#pragma unroll
            for (int i = 0; i < 8; ++i) acc[i] = 0.f;
#pragma unroll 4
            for (int qq = 0; qq < 128; ++qq) { const float v = bf2f(vl[qq * 512 + c]);
#pragma unroll
                for (int i = 0; i < 8; ++i) acc[i] += wg[(p0 + i) * 128 + qq] * v; }
#pragma unroll
            for (int i = 0; i < 8; ++i) { const size_t tok = (size_t)ch * 128 + p0 + i; const float u = gelu_tanh(bf2f(PAC[tok * N_AC + 1536 + c]));
                Y[tok * 1536 + 1024 + c] = (bf16)f2bf(u * (acc[i] + bs[g * 128 + p0 + i])); }
        }
    }
    __syncthreads();
}
__device__ __forceinline__ s16x4 tr_read8(unsigned addr) { s16x4 r; asm volatile("ds_read_b64_tr_b16 %0, %1" : "=v"(r) : "v"(addr) : "memory"); return r; }
__device__ __forceinline__ void phase_sgu(Frame& F, const Args& a, int layer) {
    const bf16* PAC = (const bf16*)(a.ws + WS_P); bf16* Y = (bf16*)(a.ws + WS_Y);
    const float* lg = a.in[6] + layer * 512; const float* lb = a.in[7] + layer * 512; const float* bs = a.in[9] + layer * 4 * 128;
    const bf16* sgw = (const bf16*)(a.ws + WS_SGW) + (size_t)layer * 4 * 128 * 128;
    constexpr int RP = 1088; static_assert(128 * RP <= MISC_OFF, "SGU LDS image");
    const int lane = F.lane, wid = F.wave, r32 = lane & 31, hi = lane >> 5;
    for (int ch = F.vcu; ch < T / 128; ch += F.G) {
        __syncthreads();
        v4u wv16[16];
#pragma unroll
        for (int i = 0; i < 16; ++i) wv16[i] = *(const v4u*)(PAC + ((size_t)ch * 128 + wid * 16 + i) * N_AC + 2048 + lane * 8);
        const f32x4 g0 = *(const f32x4*)(lg + lane * 8), g1 = *(const f32x4*)(lg + lane * 8 + 4), b0 = *(const f32x4*)(lb + lane * 8), b1 = *(const f32x4*)(lb + lane * 8 + 4);
#pragma unroll
        for (int i = 0; i < 16; ++i) { const int qq = wid * 16 + i; const v4u w = wv16[i]; float v[8];
#pragma unroll
            for (int j = 0; j < 4; ++j) { v[2 * j] = gelu_tanh(bflo(w[j])); v[2 * j + 1] = gelu_tanh(bfhi(w[j])); }
            float s1 = 0.f;
#pragma unroll
            for (int j = 0; j < 8; ++j) s1 += v[j];
            const float mu = wave_sum(s1) * (1.f / 512.f); float s2 = 0.f;
#pragma unroll
            for (int j = 0; j < 8; ++j) { v[j] -= mu; s2 += v[j] * v[j]; }
            const float rstd = 1.f / sqrtf(wave_sum(s2) * (1.f / 512.f) + EPS);
            v4u o; o.x = pk2(v[0] * rstd * g0.x + b0.x, v[1] * rstd * g0.y + b0.y); o.y = pk2(v[2] * rstd * g0.z + b0.z, v[3] * rstd * g0.w + b0.w);
            o.z = pk2(v[4] * rstd * g1.x + b1.x, v[5] * rstd * g1.y + b1.y); o.w = pk2(v[6] * rstd * g1.z + b1.z, v[7] * rstd * g1.w + b1.w);
            *(LAS v4u*)(F.lds + qq * RP + lane * 16) = o; }
        __syncthreads();
        const int g = wid >> 1, p0 = (wid & 1) * 64;
        f32x16 acc[2][4];
#pragma unroll
        for (int i = 0; i < 2; ++i)
#pragma unroll
            for (int j = 0; j < 4; ++j) acc[i][j] = f32x16{};
        const int g16 = lane >> 4, i16 = lane & 15, tq = i16 >> 2, tp = i16 & 3;
        const unsigned vbase = (unsigned)(uintptr_t)F.lds + (unsigned)((8 * hi + tq) * RP + (g * 128 + 16 * (g16 & 1) + 4 * tp) * 2);
        const bf16* wa = sgw + ((size_t)g * 128 + p0 + r32) * 128 + hi * 8;
#pragma unroll 2
        for (int ks = 0; ks < 8; ++ks) {
            const bf16x8 a0 = *(const bf16x8*)(wa + ks * 16), a1 = *(const bf16x8*)(wa + 32 * 128 + ks * 16);
            s16x4 lo[4], hh[4];
#pragma unroll
            for (int ct = 0; ct < 4; ++ct) { lo[ct] = tr_read8(vbase + ks * 16 * RP + ct * 64); hh[ct] = tr_read8(vbase + ks * 16 * RP + 4 * RP + ct * 64); }
            LDS_WAIT(); __builtin_amdgcn_sched_barrier(0);
#pragma unroll
            for (int ct = 0; ct < 4; ++ct) { const bf16x8 vb = (bf16x8){lo[ct][0], lo[ct][1], lo[ct][2], lo[ct][3], hh[ct][0], hh[ct][1], hh[ct][2], hh[ct][3]};
                acc[0][ct] = __builtin_amdgcn_mfma_f32_32x32x16_bf16(vb, a0, acc[0][ct], 0, 0, 0);
                acc[1][ct] = __builtin_amdgcn_mfma_f32_32x32x16_bf16(vb, a1, acc[1][ct], 0, 0, 0); }
        }
        constexpr int EP = 1040;
        float bsv[2];
#pragma unroll
        for (int i = 0; i < 2; ++i) bsv[i] = bs[g * 128 + p0 + i * 32 + r32];
        __syncthreads();
        v4u uu[16];
#pragma unroll
        for (int i = 0; i < 16; ++i) uu[i] = *(const v4u*)(PAC + ((size_t)ch * 128 + wid * 16 + i) * N_AC + 1536 + lane * 8);
#pragma unroll
        for (int i = 0; i < 2; ++i) { LAS unsigned char* rowp = F.lds + (p0 + i * 32 + r32) * EP + (g * 128 + 4 * hi) * 2;
#pragma unroll
            for (int ct = 0; ct < 4; ++ct)
#pragma unroll
                for (int q4 = 0; q4 < 4; ++q4) { v2u w; w.x = pk2(acc[i][ct][4 * q4] + bsv[i], acc[i][ct][4 * q4 + 1] + bsv[i]); w.y = pk2(acc[i][ct][4 * q4 + 2] + bsv[i], acc[i][ct][4 * q4 + 3] + bsv[i]);
                    *(LAS v2u*)(rowp + (ct * 32 + 8 * q4) * 2) = w; } }
        __syncthreads();
#pragma unroll
        for (int i = 0; i < 16; ++i) { const int row = wid * 16 + i; const v4u d = *(const LAS v4u*)(F.lds + row * EP + lane * 16); const v4u u = uu[i]; v4u o;
#pragma unroll
            for (int j = 0; j < 4; ++j) o[j] = pk2(gelu_tanh(bflo(u[j])) * bflo(d[j]), gelu_tanh(bfhi(u[j])) * bfhi(d[j]));
            if (!a.dry) *(v4u*)(Y + ((size_t)ch * 128 + row) * 1536 + 1024 + lane * 8) = o; else asm volatile("" :: "v"(o)); }
    }
    __syncthreads();
}
__device__ __forceinline__ void phase_dilated(Frame& F, const Args& a) {
    bf16* PB = (bf16*)(a.ws + WS_P); float* LSE = (float*)(a.ws + WS_LIST);
    LAS float* tab = (LAS float*)F.lds;
    LAS unsigned char* vt = F.lds + 20480 + F.wave * 12288;
    { const float* btb = (const float*)(a.ws + WS_BTB); float tv_[9];
#pragma unroll
      for (int k = 0; k < 9; ++k) tv_[k] = btb[F.tid + 512 * k];
#pragma unroll
      for (int k = 0; k < 9; ++k) tab[F.tid + 512 * k] = tv_[k]; }
    __syncthreads();
    const int lane = F.lane, r32 = lane & 31, hi = lane >> 5;
    const int gw = F.vcu * NWAVES + F.wave, NGW = F.G * NWAVES;
    constexpr float C = 0.125f * LOG2E;
    const int g16 = lane >> 4, i16 = lane & 15, tq = i16 >> 2, tp = i16 & 3;
    const unsigned trb = (unsigned)(uintptr_t)vt + (unsigned)((8 * hi + tq) * 192 + (16 * (g16 & 1) + 4 * tp) * 2);
#pragma unroll 1
    for (int item = gw; item < BATCH * 3 * 8 * 128; item += NGW) {
        const int tix = item & 127, hh = (item >> 7) & 7, g = (item >> 10) % 3, b = item / (128 * 8 * 3);
        const int r = g == 0 ? 1 : (g == 1 ? 4 : 16), L = SEQ / r, tps = L / 32;
        const int s = tix / tps, qt = tix % tps;
        const int qcol = g * 512 + hh * 64;
        const int lbase = qt * 32 - 64;
        const bool edge = (lbase < 0) || (lbase + 160 > L);
        const char* base = sbase((const char*)(PB + ((size_t)b * SEQ + s) * N_B + qcol));
        const unsigned rs = (unsigned)r * (unsigned)(N_B * 2);
        bf16x8 qr[4], kf[5][4];
        { const unsigned qo = (unsigned)(qt * 32 + r32) * rs + (unsigned)hi * 16u;
#pragma unroll
          for (int d0 = 0; d0 < 4; ++d0) qr[d0] = *(const bf16x8*)(base + qo + d0 * 32); }
#pragma unroll
        for (int kt = 0; kt < 5; ++kt) { int lk = lbase + kt * 32 + r32; lk = lk < 0 ? 0 : (lk >= L ? L - 1 : lk);
            const unsigned ko = (unsigned)lk * rs + (unsigned)hi * 16u + 1536u * 2u;
#pragma unroll
            for (int d0 = 0; d0 < 4; ++d0) kf[kt][d0] = *(const bf16x8*)(base + ko + d0 * 32); }
        __builtin_amdgcn_sched_barrier(0);
        f32x16 p[5];
        { const LAS float* tb = tab + (g * 8 + hh) * 192 + 32 + 4 * hi - r32;
#pragma unroll
          for (int kt = 0; kt < 5; ++kt) {
#pragma unroll
            for (int rr = 0; rr < 16; ++rr) p[kt][rr] = tb[kt * 32 + (rr & 3) + 8 * (rr >> 2)]; } }
#pragma unroll
        for (int kt = 0; kt < 5; ++kt)
#pragma unroll
            for (int d0 = 0; d0 < 4; ++d0) p[kt] = __builtin_amdgcn_mfma_f32_32x32x16_bf16(kf[kt][d0], qr[d0], p[kt], 0, 0, 0);
        __builtin_amdgcn_sched_barrier(0);
        v4u vv[5][4];
#pragma unroll
        for (int kt = 0; kt < 5; ++kt)
#pragma unroll
            for (int j = 0; j < 4; ++j) { int lk = lbase + kt * 32 + j * 8 + (lane >> 3); lk = lk < 0 ? 0 : (lk >= L ? L - 1 : lk);
                vv[kt][j] = *(const v4u*)(base + ((unsigned)lk * rs + (unsigned)(lane & 7) * 16u + 3072u * 2u)); }
        __builtin_amdgcn_sched_barrier(0);
        if (edge) {
            asm volatile("" ::: "memory");
#pragma unroll
            for (int kt = 0; kt < 5; ++kt)
#pragma unroll
                for (int rr = 0; rr < 16; ++rr) { const int lk = lbase + kt * 32 + (rr & 3) + 8 * (rr >> 2) + 4 * hi; if (lk < 0 || lk >= L) p[kt][rr] = -1e30f; } }
        float mx = p[0][0];
#pragma unroll
        for (int kt = 0; kt < 5; ++kt)
#pragma unroll
            for (int rr = 0; rr < 16; ++rr) mx = fmaxf(mx, p[kt][rr]);
        { auto sw = __builtin_amdgcn_permlane32_swap(__float_as_uint(mx), __float_as_uint(mx), false, false); mx = fmaxf(__uint_as_float(sw[0]), __uint_as_float(sw[1])); }
        const float mxc = -mx * C; float ls = 0.f;
#pragma unroll
        for (int kt = 0; kt < 5; ++kt)
#pragma unroll
            for (int rr = 0; rr < 16; ++rr) { const float e = __builtin_amdgcn_exp2f(fmaf(p[kt][rr], C, mxc)); p[kt][rr] = e; ls += e; }
        { auto sw = __builtin_amdgcn_permlane32_swap(__float_as_uint(ls), __float_as_uint(ls), false, false); ls = __uint_as_float(sw[0]) + __uint_as_float(sw[1]); }
        bf16x8 pa[5][2];
#define PK4(P, BASE, OUT) do { unsigned a0 = cvt_pk_bf16(P[BASE + 0], P[BASE + 1]), a1 = cvt_pk_bf16(P[BASE + 2], P[BASE + 3]);   \
    unsigned b0 = cvt_pk_bf16(P[BASE + 4], P[BASE + 5]), b1 = cvt_pk_bf16(P[BASE + 6], P[BASE + 7]);                              \
    auto r0 = __builtin_amdgcn_permlane32_swap(a0, b0, false, false); auto r1 = __builtin_amdgcn_permlane32_swap(a1, b1, false, false); \
    v4u w_ = {r0[0], r1[0], r0[1], r1[1]}; OUT = __builtin_bit_cast(bf16x8, w_); } while (0)
#pragma unroll
        for (int kt = 0; kt < 5; ++kt) { PK4(p[kt], 0, pa[kt][0]); PK4(p[kt], 8, pa[kt][1]); }
#undef PK4
        __builtin_amdgcn_sched_barrier(0);
        f32x16 o0 = {}, o1 = {};
#define VWRITE(kt, buf) do { _Pragma("unroll") for (int j = 0; j < 4; ++j) { const int key = j * 8 + (lane >> 3), chk = lane & 7; *(LAS v4u*)(vt + (buf) * 6144 + key * 192 + chk * 16) = vv[kt][j]; } } while (0)
#define VPV(kt, buf) do { _Pragma("unroll") for (int ks = 0; ks < 2; ++ks) { const unsigned ba_ = trb + (buf) * 6144 + ks * 16 * 192; \
        const s16x4 l0 = tr_read8(ba_), h0 = tr_read8(ba_ + 4 * 192), l1 = tr_read8(ba_ + 64), h1 = tr_read8(ba_ + 4 * 192 + 64); \
        LDS_WAIT(); __builtin_amdgcn_sched_barrier(0); \
        const bf16x8 vb0 = (bf16x8){l0[0], l0[1], l0[2], l0[3], h0[0], h0[1], h0[2], h0[3]}; const bf16x8 vb1 = (bf16x8){l1[0], l1[1], l1[2], l1[3], h1[0], h1[1], h1[2], h1[3]}; \
        o0 = __builtin_amdgcn_mfma_f32_32x32x16_bf16(vb0, pa[kt][ks], o0, 0, 0, 0); o1 = __builtin_amdgcn_mfma_f32_32x32x16_bf16(vb1, pa[kt][ks], o1, 0, 0, 0); } } while (0)
        VWRITE(0, 0); VWRITE(1, 1); LDS_WAIT(); VPV(0, 0); VPV(1, 1);
        LDS_WAIT(); VWRITE(2, 0); VWRITE(3, 1); LDS_WAIT(); VPV(2, 0); VPV(3, 1);
        LDS_WAIT(); VWRITE(4, 0); LDS_WAIT(); VPV(4, 0);
#undef VWRITE
#undef VPV
        if (a.dry) { asm volatile("" :: "v"(o0[0]), "v"(o1[5]), "v"(mx)); continue; }
        if (hi == 0) LSE[((size_t)g * T + (size_t)b * SEQ + (size_t)(qt * 32 + r32) * r + s) * 8 + hh] = mx * C + __builtin_amdgcn_logf(ls);
        { const float il = __builtin_amdgcn_rcpf(ls); LAS unsigned char* ost = vt + r32 * 144 + hi * 8;
#pragma unroll
          for (int q4 = 0; q4 < 4; ++q4) { v2u w0, w1;
            w0.x = pk2(o0[4 * q4] * il, o0[4 * q4 + 1] * il); w0.y = pk2(o0[4 * q4 + 2] * il, o0[4 * q4 + 3] * il);
            w1.x = pk2(o1[4 * q4] * il, o1[4 * q4 + 1] * il); w1.y = pk2(o1[4 * q4 + 2] * il, o1[4 * q4 + 3] * il);
            *(LAS v2u*)(ost + q4 * 16) = w0; *(LAS v2u*)(ost + 64 + q4 * 16) = w1; }
          LDS_WAIT();
#pragma unroll
          for (int ps = 0; ps < 4; ++ps) { const int row = ps * 8 + (lane >> 3); const v4u v = *(const LAS v4u*)(vt + row * 144 + (lane & 7) * 16);
            *(v4u*)((char*)base + ((unsigned)(qt * 32 + row) * rs + (unsigned)(lane & 7) * 16u)) = v; } }
        LDS_WAIT();
    }
    __syncthreads();
}
__device__ __forceinline__ void phase_dilated2(Frame& F, const Args& a) {
    bf16* PB = (bf16*)(a.ws + WS_P); float* LSE = (float*)(a.ws + WS_LIST); const float* btb = (const float*)(a.ws + WS_BTB);
    constexpr int D2_TAB = 0, D2_K = 2048, D2_V = D2_K + 384 * 128, D2_O = D2_V + 384 * 128;
    static_assert(D2_O + 8 * 4608 <= MISC_OFF, "dilated LDS map");
    const int lane = F.lane, wid = F.wave, r32 = lane & 31, hi = lane >> 5;
    constexpr float C = 0.125f * LOG2E;
    LAS unsigned char* KL = F.lds + D2_K; LAS unsigned char* VL = F.lds + D2_V; LAS unsigned char* ost = F.lds + D2_O + wid * 4608;
    int kro[4];
#pragma unroll
    for (int d0 = 0; d0 < 4; ++d0) kro[d0] = (int)(uintptr_t)KL + wid * 4096 + r32 * 128 + (((2 * d0 + hi) ^ ((r32 >> 1) & 7)) << 4);
    const int i16 = lane & 15, g16 = lane >> 4;
    const int vrd = (int)(uintptr_t)VL + (4 * wid + hi) * 1024 + (i16 >> 2) * 64 + (i16 & 3) * 8 + (g16 & 1) * 32;
    const int kR0 = wid * 48 + (lane >> 3), vR0 = wid * 48 + ((lane >> 2) & 7);
    const unsigned vcb = (unsigned)(((lane >> 5) & 1) * 64 + (lane & 3) * 16);
    int t_next = F.vcu;
    bf16x8 qr[4]; float tabv = 0.f;
#define D2_DECODE(IT, g_, hh_, b_, s_, blk_, r_, L_) const int t16_ = (IT) & 15, hh_ = ((IT) >> 4) & 7, g_ = ((IT) >> 7) % 3, b_ = (IT) / 384; \
        const int r_ = g_ == 0 ? 1 : (g_ == 1 ? 4 : 16), L_ = SEQ / r_, nb_ = L_ >> 8, s_ = t16_ / nb_, blk_ = t16_ % nb_
#define D2_ISSUE_KQT(IT) do { D2_DECODE(IT, g_, hh_, b_, s_, blk_, r_, L_); const unsigned rs_ = (unsigned)r_ * (unsigned)(N_B * 2); \
        const char* bs_ = sbase((const char*)(PB + ((size_t)b_ * SEQ + s_) * N_B + g_ * 512 + hh_ * 64)); const int lw0_ = blk_ * 256 - 64; \
        _Pragma("unroll") for (int j = 0; j < 6; ++j) { const int R_ = kR0 + 8 * j; int lk_ = lw0_ + R_; lk_ = lk_ < 0 ? 0 : (lk_ >= L_ ? L_ - 1 : lk_); \
            const unsigned so_ = (unsigned)lk_ * rs_ + 1536u * 2u + (unsigned)((((lane & 7) ^ ((R_ >> 1) & 7))) << 4); \
            __builtin_amdgcn_global_load_lds((const unsigned*)(bs_ + so_), (LAS unsigned*)(KL + (wid * 6 + j) * 1024), 16, 0, 0); } \
        { const unsigned qo_ = (unsigned)(blk_ * 256 + wid * 32 + r32) * rs_ + (unsigned)hi * 16u; \
          _Pragma("unroll") for (int d0 = 0; d0 < 4; ++d0) qr[d0] = *(const bf16x8*)(bs_ + qo_ + d0 * 32); } \
        tabv = btb[(g_ * 8 + hh_) * 192 + (F.tid < 192 ? F.tid : 0)]; } while (0)
#define D2_ISSUE_V(IT) do { D2_DECODE(IT, g_, hh_, b_, s_, blk_, r_, L_); const unsigned rs_ = (unsigned)r_ * (unsigned)(N_B * 2); \
        const char* bs_ = sbase((const char*)(PB + ((size_t)b_ * SEQ + s_) * N_B + g_ * 512 + hh_ * 64)); const int lw0_ = blk_ * 256 - 64; \
        _Pragma("unroll") for (int j = 0; j < 6; ++j) { int lk_ = lw0_ + vR0 + 8 * j; lk_ = lk_ < 0 ? 0 : (lk_ >= L_ ? L_ - 1 : lk_); \
            __builtin_amdgcn_global_load_lds((const unsigned*)(bs_ + ((unsigned)lk_ * rs_ + 3072u * 2u + vcb)), (LAS unsigned*)(VL + (wid * 6 + j) * 1024), 16, 0, 0); } } while (0)
    if (t_next < BATCH * 3 * 8 * 16) { D2_ISSUE_KQT(t_next); __builtin_amdgcn_sched_barrier(0); D2_ISSUE_V(t_next); }
    asm volatile("s_waitcnt vmcnt(0)" ::: "memory");
    int par = 0;
#pragma unroll 1
    for (int item = F.vcu; item < BATCH * 3 * 8 * 16; item += F.G) {
        D2_DECODE(item, g, hh, b, s, blk, r, L);
        const unsigned rs = (unsigned)r * (unsigned)(N_B * 2);
        const char* base = sbase((const char*)(PB + ((size_t)b * SEQ + s) * N_B + g * 512 + hh * 64));
        const int lbase = blk * 256 + wid * 32 - 64;
        const bool edge = (lbase < 0) || (lbase + 160 > L);
        LAS float* tab = (LAS float*)(F.lds + D2_TAB + par * 768);
        if (a.dry) asm volatile("s_waitcnt vmcnt(0)" ::: "memory"); else asm volatile("s_waitcnt vmcnt(11)" ::: "memory");
        if (F.tid < 192) tab[F.tid] = tabv;
        asm volatile("s_waitcnt lgkmcnt(0)" ::: "memory"); __builtin_amdgcn_s_barrier(); asm volatile("" ::: "memory");
        f32x16 p[5];
        { const LAS float* tb = tab + 32 + 4 * hi - r32;
#pragma unroll
          for (int kt = 0; kt < 5; ++kt) {
#pragma unroll
            for (int rr = 0; rr < 16; ++rr) p[kt][rr] = tb[kt * 32 + (rr & 3) + 8 * (rr >> 2)]; } }
#pragma unroll
        for (int kt = 0; kt < 5; ++kt) { bf16x8 kf[4];
#pragma unroll
            for (int d0 = 0; d0 < 4; ++d0) kf[d0] = *(const LAS bf16x8*)(uintptr_t)(unsigned)(kro[d0] + kt * 4096);
#pragma unroll
            for (int d0 = 0; d0 < 4; ++d0) p[kt] = __builtin_amdgcn_mfma_f32_32x32x16_bf16(kf[d0], qr[d0], p[kt], 0, 0, 0); }
        asm volatile("s_waitcnt vmcnt(0) lgkmcnt(0)" ::: "memory"); __builtin_amdgcn_s_barrier(); asm volatile("" ::: "memory");
        __builtin_amdgcn_sched_barrier(0);
        { const int nx = item + F.G < BATCH * 3 * 8 * 16 ? item + F.G : item; D2_ISSUE_KQT(nx); }
        __builtin_amdgcn_sched_barrier(0);
        if (edge) {
            asm volatile("" ::: "memory");
#pragma unroll
            for (int kt = 0; kt < 5; ++kt)
#pragma unroll
                for (int rr = 0; rr < 16; ++rr) { const int lk = lbase + kt * 32 + (rr & 3) + 8 * (rr >> 2) + 4 * hi; if (lk < 0 || lk >= L) p[kt][rr] = -1e30f; } }
        float mx = p[0][0];
#pragma unroll
        for (int kt = 0; kt < 5; ++kt)
#pragma unroll
            for (int rr = 0; rr < 16; ++rr) mx = fmaxf(mx, p[kt][rr]);
        { auto sw = __builtin_amdgcn_permlane32_swap(__float_as_uint(mx), __float_as_uint(mx), false, false); mx = fmaxf(__uint_as_float(sw[0]), __uint_as_float(sw[1])); }
        const float mxc = -mx * C; float ls = 0.f;
#pragma unroll
        for (int kt = 0; kt < 5; ++kt)
#pragma unroll
            for (int rr = 0; rr < 16; ++rr) { const float e = __builtin_amdgcn_exp2f(fmaf(p[kt][rr], C, mxc)); p[kt][rr] = e; ls += e; }
        { auto sw = __builtin_amdgcn_permlane32_swap(__float_as_uint(ls), __float_as_uint(ls), false, false); ls = __uint_as_float(sw[0]) + __uint_as_float(sw[1]); }
        bf16x8 pa[5][2];
#define PK4(P, BASE, OUT) do { unsigned a0 = cvt_pk_bf16(P[BASE + 0], P[BASE + 1]), a1 = cvt_pk_bf16(P[BASE + 2], P[BASE + 3]);   \
    unsigned b0 = cvt_pk_bf16(P[BASE + 4], P[BASE + 5]), b1 = cvt_pk_bf16(P[BASE + 6], P[BASE + 7]);                              \
    auto r0 = __builtin_amdgcn_permlane32_swap(a0, b0, false, false); auto r1 = __builtin_amdgcn_permlane32_swap(a1, b1, false, false); \
    v4u w_ = {r0[0], r1[0], r0[1], r1[1]}; OUT = __builtin_bit_cast(bf16x8, w_); } while (0)
#pragma unroll
        for (int kt = 0; kt < 5; ++kt) { PK4(p[kt], 0, pa[kt][0]); PK4(p[kt], 8, pa[kt][1]); }
#undef PK4
        __builtin_amdgcn_sched_barrier(0);
        f32x16 o0 = {}, o1 = {};
#define D2_VF(kt, ks, cb, LO, HI4) do { LO = da::tr_read<((4 * (kt) + 2 * (ks)) * 1024 + (cb) * 512)>(vrd); HI4 = da::tr_read<((4 * (kt) + 2 * (ks)) * 1024 + (cb) * 512 + 256)>(vrd); } while (0)
#define D2_PKV(L_, H_) (bf16x8){L_[0], L_[1], L_[2], L_[3], H_[0], H_[1], H_[2], H_[3]}
#define D2_TILE(kt) do { s16x4 l00, h00, l01, h01, l10, h10, l11, h11; D2_VF(kt, 0, 0, l00, h00); D2_VF(kt, 0, 1, l01, h01); D2_VF(kt, 1, 0, l10, h10); D2_VF(kt, 1, 1, l11, h11); \
            LDS_WAIT(); __builtin_amdgcn_sched_barrier(0); \
            o0 = __builtin_amdgcn_mfma_f32_32x32x16_bf16(D2_PKV(l00, h00), pa[kt][0], o0, 0, 0, 0); o1 = __builtin_amdgcn_mfma_f32_32x32x16_bf16(D2_PKV(l01, h01), pa[kt][0], o1, 0, 0, 0); \
            o0 = __builtin_amdgcn_mfma_f32_32x32x16_bf16(D2_PKV(l10, h10), pa[kt][1], o0, 0, 0, 0); o1 = __builtin_amdgcn_mfma_f32_32x32x16_bf16(D2_PKV(l11, h11), pa[kt][1], o1, 0, 0, 0); } while (0)
        D2_TILE(0); D2_TILE(1); D2_TILE(2); D2_TILE(3); D2_TILE(4);
#undef D2_TILE
#undef D2_PKV
#undef D2_VF
        asm volatile("s_waitcnt lgkmcnt(0)" ::: "memory"); __builtin_amdgcn_s_barrier(); asm volatile("" ::: "memory");
        __builtin_amdgcn_sched_barrier(0);
        { const int nx = item + F.G < BATCH * 3 * 8 * 16 ? item + F.G : item; D2_ISSUE_V(nx); }
        __builtin_amdgcn_sched_barrier(0);
        par ^= 1;
        if (a.dry) { asm volatile("" :: "v"(o0[0]), "v"(o1[5]), "v"(mx)); continue; }
        if (hi == 0) LSE[((size_t)g * T + (size_t)b * SEQ + (size_t)(blk * 256 + wid * 32 + r32) * r + s) * 8 + hh] = mx * C + __builtin_amdgcn_logf(ls);
        { const float il = __builtin_amdgcn_rcpf(ls); LAS unsigned char* op = ost + r32 * 144 + hi * 8;
#pragma unroll
          for (int q4 = 0; q4 < 4; ++q4) { v2u w0, w1;
            w0.x = pk2(o0[4 * q4] * il, o0[4 * q4 + 1] * il); w0.y = pk2(o0[4 * q4 + 2] * il, o0[4 * q4 + 3] * il);
            w1.x = pk2(o1[4 * q4] * il, o1[4 * q4 + 1] * il); w1.y = pk2(o1[4 * q4 + 2] * il, o1[4 * q4 + 3] * il);
            *(LAS v2u*)(op + q4 * 16) = w0; *(LAS v2u*)(op + 64 + q4 * 16) = w1; }
          LDS_WAIT();
#pragma unroll
          for (int ps = 0; ps < 4; ++ps) { const int row = ps * 8 + (lane >> 3); const v4u v = *(const LAS v4u*)(ost + row * 144 + (lane & 7) * 16);
            *(v4u*)((char*)base + ((unsigned)(blk * 256 + wid * 32 + row) * rs + (unsigned)(lane & 7) * 16u)) = v; } }
        LDS_WAIT();
    }
    asm volatile("s_waitcnt vmcnt(0)" ::: "memory");
    __syncthreads();
#undef D2_DECODE
#undef D2_ISSUE_KQT
#undef D2_ISSUE_V
}
__device__ __forceinline__ void phase_dilated_combine(Frame& F, const Args& a) {
    const bf16* PB = (const bf16*)(a.ws + WS_P); const float* LSE = (const float*)(a.ws + WS_LIST); bf16* Y = (bf16*)(a.ws + WS_Y);
    const int gw = F.vcu * NWAVES + F.wave, NGW = F.G * NWAVES, lane = F.lane, hh = lane >> 3;
#pragma unroll 1
    for (int m0 = gw; m0 < T; m0 += 4 * NGW) {
        float ls[4][3]; v4u ov[4][3];
#pragma unroll
        for (int u = 0; u < 4; ++u) { const int m = m0 + u * NGW < T ? m0 + u * NGW : m0;
#pragma unroll
            for (int g = 0; g < 3; ++g) { ls[u][g] = LSE[((size_t)g * T + m) * 8 + hh]; ov[u][g] = *(const v4u*)(PB + (size_t)m * N_B + g * 512 + lane * 8); } }
#pragma unroll
        for (int u = 0; u < 4; ++u) { const int m = m0 + u * NGW; if (m >= T) break;
            const float l0 = ls[u][0], l1 = ls[u][1], l2 = ls[u][2];
            const float mx = fmaxf(l0, fmaxf(l1, l2)); const float e0 = __builtin_amdgcn_exp2f(l0 - mx), e1 = __builtin_amdgcn_exp2f(l1 - mx), e2 = __builtin_amdgcn_exp2f(l2 - mx);
            const float inv = 1.f / (e0 + e1 + e2); const float w[3] = {e0 * inv, e1 * inv, e2 * inv};
            float y[8];
#pragma unroll
            for (int j = 0; j < 8; ++j) y[j] = 0.f;
#pragma unroll
            for (int g = 0; g < 3; ++g) { const v4u uu = ov[u][g];
#pragma unroll
                for (int j = 0; j < 4; ++j) { y[2 * j] += w[g] * bflo(uu[j]); y[2 * j + 1] += w[g] * bfhi(uu[j]); } }
            v4u o; o.x = pk2(y[0], y[1]); o.y = pk2(y[2], y[3]); o.z = pk2(y[4], y[5]); o.w = pk2(y[6], y[7]);
            *(v4u*)(Y + (size_t)m * 1536 + 512 + lane * 8) = o; }
    }
}

constexpr int PH_PER_LAYER = 14, N_PHASES = 1 + DEPTH * PH_PER_LAYER;
template <int VAR> __global__ void __launch_bounds__(NWAVES * 64, 2) fwd(Args args) {
    extern __shared__ __attribute__((aligned(16))) unsigned char lds_raw[];
    Frame F;
    F.lds = (LAS unsigned char*)lds_raw; F.MISC = (volatile LAS unsigned*)(F.lds + MISC_OFF);
    F.tid = threadIdx.x; F.lane = F.tid & 63; F.wave = __builtin_amdgcn_readfirstlane(F.tid >> 6);
    F.G = gridDim.x; { const int bx = blockIdx.x; F.vcu = (F.G % 8 == 0) ? (bx % 8) * (F.G / 8) + bx / 8 : bx; }
    F.ctl = (unsigned*)(args.ws + WS_CTL);
    for (int u = F.tid; u < (LDS_BYTES - MISC_OFF) / 4; u += NWAVES * 64) ((LAS unsigned*)(F.lds + MISC_OFF))[u] = 0u;
    __syncthreads();
    XcdBarrier bar; bar.bar = F.ctl + CW_BAR; bar.x = 0; bar.st = nullptr;
#if MK_ONE_LAUNCH
    bar = xcd_barrier_post(F.ctl + CW_BAR, F.MISC + 8);
#define GRID_BAR() do { asm volatile("" : "+s"(bar.bar), "+s"(bar.x)); xcd_barrier(bar); } while (0)
#else
#define GRID_BAR() do {} while (0)
#endif
    const int lo = args.ph_lo, hi = args.ph_hi;
#define IN(k) (lo <= (k) && (k) < hi)
#define PB() do { int t_ = threadIdx.x; asm volatile("" : "+v"(t_)); F.tid = t_; F.lane = t_ & 63; { size_t z_ = 0; asm volatile("" : "+s"(z_)); args.ws += z_; args.out += z_; } } while (0)
#define SEAM(k) do { if (IN(k) && IN((k) + 1)) GRID_BAR(); } while (0)
#define WS_ (args.ws)
#define H_ ((bf16*)(args.ws + WS_H))
#define Y_ ((bf16*)(args.ws + WS_Y))
#define P_ ((bf16*)(args.ws + WS_P))
#define X_ (args.out)

    if (IN(0) && PHE(100)) { PB(); convert_mixer_weights(F, args, 0); build_bias_tables(F, args); phase_norm(F, args.in[0], args.in[2], H_, WS_ + WS_H8); }
    SEAM(0);
#pragma unroll 1
    for (int layer = 0; layer < DEPTH; ++layer) {
        const int pb = 1 + layer * PH_PER_LAYER;
        if (IN(pb + 0) && PHE(0)) { PB(); PInProj<false> p; p.A = (const char*)H_; p.B = (const char*)(WS_ + WS_WIN); p.nM = T / 256; p.nN = N_AC / 256; p.G = F.G; p.c = blockIdx.x; p.O = P_; p.ldc = N_AC; pg8::gemm_phase(F.lds, p); }
        SEAM(pb + 0);
        if (IN(pb + 1) && PHE(1)) { PB(); phase_attnA<VAR>(F, args, layer); }
        if (IN(pb + 2) && PHE(2)) { PB(); phase_sgu(F, args, layer); }
        SEAM(pb + 2);
        if (IN(pb + 3) && PHE(3)) { PB(); PInProj<false, true> p; p.A = (const char*)(WS_ + WS_H8); p.B = (const char*)(WS_ + WS_WIN) + (size_t)N_AC * 1024 * 2; p.nM = T / 256; p.nN = N_B / 256; p.G = F.G; p.c = blockIdx.x; p.O = P_; p.ldc = N_B; pg8::gemm_phase(F.lds, p); }
        SEAM(pb + 3);
        if (IN(pb + 4) && PHE(4)) { PB(); phase_dilated2(F, args); }
        SEAM(pb + 4);
        if (IN(pb + 5) && PHE(5)) { PB(); phase_dilated_combine(F, args); }
        SEAM(pb + 5);
        if (IN(pb + 6) && PHE(6)) { PB(); PInProj<true, true> p; p.A = (const char*)(WS_ + WS_H8); p.B = (const char*)(WS_ + WS_WIN) + (size_t)(N_AC + N_B) * 1024 * 2; p.nM = T / 256; p.nN = N_G / 256; p.G = F.G; p.c = blockIdx.x; p.O = P_; p.ldc = N_G; pg8::gemm_phase(F.lds, p); }
        SEAM(pb + 6);
        if (IN(pb + 7) && PHE(7)) { PB(); PMerge p; p.A = (const char*)Y_; p.B = (const char*)(WS_ + WS_WBR); p.nM = T / 256; p.nN = 4; p.G = F.G; p.c = blockIdx.x; p.PG = P_; p.O = H_; pg8::gemm_phase(F.lds, p); }
        SEAM(pb + 7);
        if (IN(pb + 8) && PHE(8)) { PB(); POut p; p.A = (const char*)H_; p.B = (const char*)(WS_ + WS_WOUT); p.nM = T / 256; p.nN = 4; p.G = F.G; p.c = blockIdx.x; p.base = layer == 0 ? args.in[0] : X_; p.X = X_; pg8::gemm_phase(F.lds, p); }
        SEAM(pb + 8);
        if (IN(pb + 9) && PHE(9)) { PB(); phase_router(F, args, layer, X_, H_); }
        if (IN(pb + 10) && PHE(10)) { PB(); convert_expert_weights(F, args, layer); if (layer + 1 < DEPTH) convert_mixer_weights(F, args, layer + 1); }
        SEAM(pb + 10);
        if (IN(pb + 11) && PHE(11)) { PB(); moe_table(F, layer); PGateUp p; p.tp = (const volatile LAS int*)(F.MISC + 16); p.list = (const int*)(WS_ + WS_LIST); p.tw = (const float*)(WS_ + WS_TW); p.ncol = 8; p.G = F.G; p.c = F.vcu;
            p.A = (const char*)H_; p.W = (const char*)(WS_ + WS_WGU); p.hid = (unsigned char*)P_; pg8::gemm_phase(F.lds, p); }
        SEAM(pb + 11);
        if (IN(pb + 12) && PHE(12)) { PB(); moe_table(F, layer); PDown p; p.tp = (const volatile LAS int*)(F.MISC + 16); p.list = (const int*)(WS_ + WS_LIST); p.tw = (const float*)(WS_ + WS_TW); p.ncol = 4; p.G = F.G; p.c = F.vcu;
            p.A = (const char*)P_; p.W = (const char*)(WS_ + WS_WD); p.X = X_; p.dry = args.dry; pg8::gemm_phase(F.lds, p); }
        SEAM(pb + 12);
        if (IN(pb + 13) && PHE(13)) { PB(); if (layer + 1 < DEPTH) phase_norm(F, X_, args.in[2] + (size_t)(layer + 1) * DM, H_, WS_ + WS_H8); else phase_final_norm(F, X_, args.in[20]); }
        SEAM(pb + 13);
    }
}

extern "C" void kernel_launch(void* const* d_in, const int* in_sizes, int n_in, void* d_out, int out_size, void* d_ws, size_t ws_size, hipStream_t stream) {
    static int grid = 0;
    if (grid == 0) {
        if (n_in != 21 || out_size != T * DM || ws_size < WS_END) { fprintf(stderr, "kernel_launch: unexpected shapes: n_in %d out %d ws %zu (need %zu)\n", n_in, out_size, ws_size, (size_t)WS_END); grid = -1; return; }
        int dev = 0, cus = 0;
        if (hipGetDevice(&dev) != hipSuccess || hipDeviceGetAttribute(&cus, hipDeviceAttributeMultiprocessorCount, dev) != hipSuccess) { grid = -1; return; }
        if (hipFuncSetAttribute((const void*)fwd<0>, hipFuncAttributeMaxDynamicSharedMemorySize, LDS_BYTES) != hipSuccess || hipFuncSetAttribute((const void*)fwd<PROBE_VAR>, hipFuncAttributeMaxDynamicSharedMemorySize, LDS_BYTES) != hipSuccess) { fprintf(stderr, "kernel_launch: hipFuncSetAttribute failed\n"); grid = -1; return; }
        int per_cu = 0; (void)hipOccupancyMaxActiveBlocksPerMultiprocessor(&per_cu, (const void*)fwd<0>, NWAVES * 64, LDS_BYTES); (void)hipGetLastError();
        grid = cus;
    }
    if (grid < 0) return;
    if (hipMemsetAsync((char*)d_ws + WS_CTL, 0, CTL_ZERO_BYTES, stream) != hipSuccess) return;
    Args a{};
    for (int i = 0; i < 21; ++i) a.in[i] = (const float*)d_in[i];
    a.out = (float*)d_out; a.ws = (unsigned char*)d_ws;
#if MK_ONE_LAUNCH
    a.ph_lo = 0; a.ph_hi = N_PHASES;
    hipLaunchKernelGGL(fwd<0>, dim3(grid), dim3(NWAVES * 64), LDS_BYTES, stream, a);
#else
    for (int ph = 0; ph < N_PHASES; ++ph) { a.ph_lo = ph; a.ph_hi = ph + 1; const int k = ph == 0 ? 31 : (ph - 1) % PH_PER_LAYER; const int nrep = ((HOST_DUPMASK >> k) & 1) ? 2 : 1;
        for (int r = 0; r < nrep; ++r) { a.dry = r; if (r == 0) hipLaunchKernelGGL(fwd<0>, dim3(grid), dim3(NWAVES * 64), LDS_BYTES, stream, a); else hipLaunchKernelGGL(fwd<PROBE_VAR>, dim3(grid), dim3(NWAVES * 64), LDS_BYTES, stream, a); } }
#endif
}
```
